# Optimizing an MI355X kernel written in HIP

```python
import math
import jax, jax.numpy as jnp
from jax import lax
import numpy as np

D_MODEL = 2048
BATCH = 16
SEQ = 2048
DEPTH = 2

EXPAND = 2
D_INNER = EXPAND * D_MODEL
N_MIXERS = 2
N_A = (DEPTH + 1) // 2
N_B = DEPTH // 2
N_HEADS = 32
HEAD_DIM = D_INNER // N_HEADS
KV_LORA = 256
IDX_HEADS = 16
IDX_DIM = 64
TOP_K_MAX = 256
Q_BLOCK = 128
A_SIZES = (D_INNER, KV_LORA, IDX_HEADS * IDX_DIM, IDX_DIM, IDX_HEADS, D_INNER)
A_IN = D_INNER + KV_LORA + IDX_HEADS * IDX_DIM + IDX_DIM + IDX_HEADS + D_INNER
A_SPLITS = (D_INNER,
            D_INNER + KV_LORA,
            D_INNER + KV_LORA + IDX_HEADS * IDX_DIM,
            D_INNER + KV_LORA + IDX_HEADS * IDX_DIM + IDX_DIM,
            D_INNER + KV_LORA + IDX_HEADS * IDX_DIM + IDX_DIM + IDX_HEADS)
REL_BUCKETS = 32
REL_MAX_DIST = 128
POOL_WINDOWS = (2, 4, 8, 16)
N_POOL_GROUPS = 4
POOL_GROUP = D_INNER // N_POOL_GROUPS
EPS = 1e-6

kernel_name = "hybrid_dsa_pool_interleaved"


def rmsnorm(x, g):
    xf = x.astype(jnp.float32)
    y = xf * lax.rsqrt(jnp.mean(xf * xf, axis=-1, keepdims=True) + EPS)
    return (y * g.astype(jnp.float32)).astype(x.dtype)


def t5_bucket(dist):
    max_exact = REL_BUCKETS // 2
    d = jnp.maximum(dist, 0)
    df = jnp.maximum(d, 1).astype(jnp.float32)
    large = max_exact + (jnp.log(df / max_exact) / math.log(REL_MAX_DIST / max_exact)
                         * (REL_BUCKETS - max_exact)).astype(jnp.int32)
    large = jnp.minimum(large, REL_BUCKETS - 1)
    return jnp.where(d < max_exact, d, large)


def dsa_mixer(h, w_in, kv_norm, kidx_norm, w_uk, w_uv, w_out, rel_bias):
    B, L, _ = h.shape
    proj = h @ w_in
    q, c_kv, q_idx, k_idx, w_idx, z = jnp.split(proj, list(A_SPLITS), axis=-1)
    q = q.reshape(B, L, N_HEADS, HEAD_DIM)
    c_kv = rmsnorm(c_kv, kv_norm)
    q_idx = q_idx.reshape(B, L, IDX_HEADS, IDX_DIM)
    k_idx = rmsnorm(k_idx, kidx_norm).astype(jnp.float32)
    w_idx = w_idx * (IDX_HEADS ** -0.5)
    top_k = min(TOP_K_MAX, L // 4)
    n_blk = L // Q_BLOCK
    key_pos = jnp.arange(L)

    def to_blocks(a):
        return a.reshape(B, n_blk, Q_BLOCK, *a.shape[2:]).swapaxes(0, 1)

    def block_fn(args):
        blk, qb, qib, wb = args
        t_pos = blk * Q_BLOCK + jnp.arange(Q_BLOCK)
        s = jnp.einsum("bthd,bsd->bths", qib.astype(jnp.float32), k_idx) * (IDX_DIM ** -0.5)
        score = jnp.einsum("bth,bths->bts", wb.astype(jnp.float32), jax.nn.relu(s))
        causal = key_pos[None, :] <= t_pos[:, None]
        score = jnp.where(causal[None], score, -jnp.inf)
        _, idx = lax.top_k(score, top_k)
        valid = idx <= t_pos[None, :, None]
        c_sel = jax.vmap(lambda c, i: c[i])(c_kv, idx)
        q_lat = jnp.einsum("bthd,chd->bthc", qb, w_uk)
        logits = jnp.einsum("bthc,btkc->bthk", q_lat, c_sel).astype(jnp.float32) * (HEAD_DIM ** -0.5)
        bias = rel_bias[t5_bucket(t_pos[None, :, None] - idx)]
        logits = logits + jnp.swapaxes(bias, 2, 3).astype(jnp.float32)
        logits = jnp.where(valid[:, :, None, :], logits, -jnp.inf)
        p = jax.nn.softmax(logits, axis=-1).astype(c_sel.dtype)
        o_lat = jnp.einsum("bthk,btkc->bthc", p, c_sel)
        return jnp.einsum("bthc,chd->bthd", o_lat, w_uv)

    out = lax.map(block_fn, (jnp.arange(n_blk), to_blocks(q), to_blocks(q_idx), to_blocks(w_idx)))
    out = out.swapaxes(0, 1).reshape(B, L, D_INNER)
    y = out * jax.nn.silu(z)
    return y @ w_out


def pool_mixer(h, w_in, w_grp, b_grp, scale, w_out):
    B, L, _ = h.shape
    u, z = jnp.split(h @ w_in, 2, axis=-1)
    ug = u.reshape(B, L, N_POOL_GROUPS, POOL_GROUP).astype(jnp.float32)
    cs = jnp.concatenate([jnp.zeros_like(ug[:, :1]), jnp.cumsum(ug, axis=1)], axis=1)
    pos = jnp.arange(L)
    win = jnp.array(POOL_WINDOWS, dtype=jnp.int32)
    start = jnp.maximum(pos[:, None] - win[None, :] + 1, 0)
    cnt = (pos[:, None] - start + 1).astype(jnp.float32)
    lo = cs[:, start, jnp.arange(N_POOL_GROUPS)]
    pooled = (cs[:, 1:] - lo) / cnt[None, :, :, None] - ug
    mixed = jnp.einsum("blgp,gpq->blgq", pooled, w_grp.astype(jnp.float32)) + b_grp.astype(jnp.float32)
    mixed = mixed.reshape(B, L, D_INNER) * scale.astype(jnp.float32)
    y = mixed.astype(h.dtype) * jax.nn.silu(z)
    return y @ w_out


def setup_inputs(seed: int = 0) -> dict:
    key = jax.random.key(seed)
    ks = jax.random.split(key, 20)
    f32 = jnp.float32
    nrm = lambda k, shp, s: jax.random.normal(k, shp, f32) * s
    return {
        "x": nrm(ks[0], (BATCH, SEQ, D_MODEL), 1.0),
        "norm_a": 1.0 + nrm(ks[1], (N_A, D_MODEL), 0.05),
        "w_in_a": nrm(ks[2], (N_A, D_MODEL, A_IN), D_MODEL ** -0.5),
        "kv_norm_a": 1.0 + nrm(ks[3], (N_A, KV_LORA), 0.05),
        "kidx_norm_a": 1.0 + nrm(ks[4], (N_A, IDX_DIM), 0.05),
        "w_uk_a": nrm(ks[5], (N_A, KV_LORA, N_HEADS, HEAD_DIM), KV_LORA ** -0.5),
        "w_uv_a": nrm(ks[6], (N_A, KV_LORA, N_HEADS, HEAD_DIM), KV_LORA ** -0.5),
        "w_out_a": nrm(ks[7], (N_A, D_INNER, D_MODEL), D_INNER ** -0.5),
        "norm_b": 1.0 + nrm(ks[8], (N_B, D_MODEL), 0.05),
        "w_in_b": nrm(ks[9], (N_B, D_MODEL, 2 * D_INNER), D_MODEL ** -0.5),
        "w_grp_b": nrm(ks[10], (N_B, N_POOL_GROUPS, POOL_GROUP, POOL_GROUP), POOL_GROUP ** -0.5),
        "b_grp_b": nrm(ks[11], (N_B, N_POOL_GROUPS, POOL_GROUP), 0.02),
        "scale_b": 1.0 + nrm(ks[12], (N_B, D_INNER), 0.1),
        "w_out_b": nrm(ks[13], (N_B, D_INNER, D_MODEL), D_INNER ** -0.5),
        "rel_bias": nrm(ks[14], (REL_BUCKETS, N_HEADS), 0.5),
        "final_norm": 1.0 + nrm(ks[15], (D_MODEL,), 0.05),
    }


def reference(x, norm_a, w_in_a, kv_norm_a, kidx_norm_a, w_uk_a, w_uv_a, w_out_a,
              norm_b, w_in_b, w_grp_b, b_grp_b, scale_b, w_out_b, rel_bias, final_norm):
    h = x
    for i in range(DEPTH):
        j = i // N_MIXERS
        if i % N_MIXERS == 0:
            h = h + dsa_mixer(rmsnorm(h, norm_a[j]), w_in_a[j], kv_norm_a[j], kidx_norm_a[j],
                              w_uk_a[j], w_uv_a[j], w_out_a[j], rel_bias)
        else:
            h = h + pool_mixer(rmsnorm(h, norm_b[j]), w_in_b[j], w_grp_b[j], b_grp_b[j],
                               scale_b[j], w_out_b[j])
    return rmsnorm(h, final_norm)
```

```cpp
#include <hip/hip_runtime.h>
#include <hip/hip_cooperative_groups.h>
#include <cstdio>
#include <cstdint>
namespace cg = cooperative_groups;

#define LAS __attribute__((address_space(3)))
typedef unsigned short bf16_t;
typedef short bf16x8 __attribute__((ext_vector_type(8)));
typedef short s16x4 __attribute__((ext_vector_type(4)));
typedef float f32x4 __attribute__((ext_vector_type(4)));
typedef float f32x16 __attribute__((ext_vector_type(16)));
typedef unsigned u32x4 __attribute__((ext_vector_type(4)));
typedef unsigned u32x2 __attribute__((ext_vector_type(2)));

constexpr int T = 32768, L = 2048, D = 2048, DI = 4096;
constexpr float EPS = 1e-6f;
constexpr float LOG2E = 1.4426950408889634f;
constexpr int LDS_BYTES = 156 * 1024;
#ifndef PROBE_PHASE
#define PROBE_PHASE -1
#endif

constexpr size_t OFF_RQ = 0;
constexpr size_t OFF_RZ = 268435456;
constexpr size_t OFF_QL0 = 536870912;
constexpr size_t OFF_XQ = OFF_QL0 + 134217728;
constexpr size_t OFF_WOUTA = 805306368;
constexpr size_t OFF_WB = OFF_WOUTA + 16777216;
constexpr int LDH = 2112, LDWB = 2112;
constexpr size_t OFF_WU = OFF_WB + (size_t)8192 * LDWB * 2;
constexpr size_t OFF_WG = OFF_WU + 16777216;
constexpr size_t OFF_WOUTB = OFF_WG + 8388608;
constexpr size_t OFF_WUK = OFF_WOUTB + 16777216;
constexpr size_t OFF_WUV = OFF_WUK + 2097152;
constexpr size_t OFF_WA = OFF_WUV + 4194304;
constexpr size_t OFF_WAI = OFF_WA + (size_t)8192 * 2048;
constexpr size_t OFF_IDX = OFF_WA;
constexpr size_t OFF_CKVN = OFF_WA + 16777216;
constexpr size_t OFF_CKVR = OFF_WA + 39845888;
constexpr size_t OFF_QIDX = OFF_CKVR + 33554432;
constexpr size_t OFF_KIDX = OFF_QIDX + 67108864;
constexpr size_t OFF_WIDX = OFF_KIDX + 4194304;
constexpr size_t OFF_SS = OFF_WIDX + 2097152;
constexpr size_t OFF_BAR = OFF_SS + 3 * 131072;
constexpr size_t OFF_SMALL = OFF_BAR + 256;
constexpr int SM_KIDXN = 0, SM_KVN = 64, SM_RELB = 320, SM_BGRP = 1344, SM_SCALE = 5440, SM_FINAL = 9536, SM_TOTAL = 11584;
constexpr size_t WS_END = OFF_SMALL + (size_t)SM_TOTAL * 4;

struct Params {
  const float *x, *norm_a, *w_in_a, *kv_norm, *kidx_norm, *w_uk, *w_uv, *w_out_a, *norm_b, *w_in_b, *w_grp, *b_grp, *scale_b, *w_out_b, *rel_bias, *final_norm;
  float* out; unsigned char* ws; int probe; int pad;
};

__device__ __forceinline__ unsigned cvt_pk_bf16(float lo, float hi) { unsigned r; asm("v_cvt_pk_bf16_f32 %0, %1, %2" : "=v"(r) : "v"(lo), "v"(hi)); return r; }
__device__ __forceinline__ float bf2f(unsigned short b) { return __uint_as_float(((unsigned)b) << 16); }
__device__ __forceinline__ float bflo(unsigned w) { return __uint_as_float(w << 16); }
__device__ __forceinline__ float bfhi(unsigned w) { return __uint_as_float(w & 0xffff0000u); }
__device__ __forceinline__ u32x4 pack8(f32x4 a, f32x4 b) { u32x4 w; w[0] = cvt_pk_bf16(a[0], a[1]); w[1] = cvt_pk_bf16(a[2], a[3]); w[2] = cvt_pk_bf16(b[0], b[1]); w[3] = cvt_pk_bf16(b[2], b[3]); return w; }
__device__ __forceinline__ float sx(float v, int mask, int lane) { return __int_as_float(__builtin_amdgcn_ds_bpermute((lane ^ mask) << 2, __float_as_int(v))); }
typedef unsigned u32x2s __attribute__((ext_vector_type(2)));
__device__ __forceinline__ float pmax16(float x) { const u32x2s r = __builtin_amdgcn_permlane16_swap(__float_as_uint(x), __float_as_uint(x), false, false); return __builtin_amdgcn_fmed3f(__uint_as_float(r[0]), __uint_as_float(r[1]), __builtin_inff()); }
__device__ __forceinline__ float pmax32(float x) { const u32x2s r = __builtin_amdgcn_permlane32_swap(__float_as_uint(x), __float_as_uint(x), false, false); return __builtin_amdgcn_fmed3f(__uint_as_float(r[0]), __uint_as_float(r[1]), __builtin_inff()); }
__device__ __forceinline__ float psum16(float x) { const u32x2s r = __builtin_amdgcn_permlane16_swap(__float_as_uint(x), __float_as_uint(x), false, false); return __uint_as_float(r[0]) + __uint_as_float(r[1]); }
__device__ __forceinline__ float psum32(float x) { const u32x2s r = __builtin_amdgcn_permlane32_swap(__float_as_uint(x), __float_as_uint(x), false, false); return __uint_as_float(r[0]) + __uint_as_float(r[1]); }
template <int CTRL> __device__ __forceinline__ float dppf(float x) { return __int_as_float(__builtin_amdgcn_update_dpp(0, __float_as_int(x), CTRL, 0xf, 0xf, false)); }
__device__ __forceinline__ float vmin(float a, float b) { return __builtin_amdgcn_fmed3f(a, b, -__builtin_inff()); }
__device__ __forceinline__ float pmin16(float x) { const u32x2s r = __builtin_amdgcn_permlane16_swap(__float_as_uint(x), __float_as_uint(x), false, false); return vmin(__uint_as_float(r[0]), __uint_as_float(r[1])); }
__device__ __forceinline__ float pmin32(float x) { const u32x2s r = __builtin_amdgcn_permlane32_swap(__float_as_uint(x), __float_as_uint(x), false, false); return vmin(__uint_as_float(r[0]), __uint_as_float(r[1])); }
__device__ __forceinline__ float wave_sum(float s, int) { s += dppf<0x128>(s); s += dppf<0x124>(s); s += dppf<0x122>(s); s += dppf<0x121>(s); return psum32(psum16(s)); }
__device__ __forceinline__ float wave_max(float s) { s = __builtin_amdgcn_fmed3f(s, dppf<0x128>(s), __builtin_inff()); s = __builtin_amdgcn_fmed3f(s, dppf<0x124>(s), __builtin_inff()); s = __builtin_amdgcn_fmed3f(s, dppf<0x122>(s), __builtin_inff()); s = __builtin_amdgcn_fmed3f(s, dppf<0x121>(s), __builtin_inff()); return pmax32(pmax16(s)); }
__device__ __forceinline__ float wave_min(float s) { s = vmin(s, dppf<0x128>(s)); s = vmin(s, dppf<0x124>(s)); s = vmin(s, dppf<0x122>(s)); s = vmin(s, dppf<0x121>(s)); return pmin32(pmin16(s)); }
__device__ __forceinline__ float vmax(float a, float b) { return __builtin_amdgcn_fmed3f(a, b, __builtin_inff()); }
__device__ __forceinline__ float relu_i(float x) { return __int_as_float(max(__float_as_int(x), 0)); }
__device__ __forceinline__ float silu(float z) { return z / (1.f + __expf(-z)); }
__device__ __forceinline__ float silu_fast(float z) { return z * __builtin_amdgcn_rcpf(1.f + __builtin_amdgcn_exp2f(-1.4426950408889634f * z)); }

namespace g8 {
constexpr int BM = 256, BK = 64, HALF = 128, HTB = HALF * BK * 2, STAGE_BYTES = 8 * HTB, NXCD = 8, WGM = 2;
__device__ __forceinline__ int lds_byte(int r, int c) { const int st = (r >> 4) * 2 + (c >> 5), rr = r & 15, cc = c & 31, ob = rr * 64 + cc * 2; return st * 1024 + (ob ^ (((ob >> 9) & 1) << 5)); }
__device__ __forceinline__ void stage_rc(int b, int& R, int& C) { const int st = b / 1024, sb = b % 1024, swz = sb ^ (((sb >> 9) & 1) << 5); R = (st >> 1) * 16 + swz / 64; C = (st & 1) * 32 + (swz % 64) / 2; }
__device__ __forceinline__ int perm32(int rho) { const int n = rho >> 4, i = rho & 15; return 8 * (i >> 2) + 4 * n + (i & 3); }

struct GUnit { const char* A; const char* B; int pm, pn; };

struct Sched {
  int nM, nN, nwg, G, c;
  const char* A0; const char* A1; int pmSplit; size_t sAm, sAn;
  const char* B0; size_t sBn, sBg; int gshift; int anshift;
  __device__ __forceinline__ void init(int nM_, int nN_, int G_, int c_) { nM = nM_; nN = nN_; nwg = nM * nN; G = G_; c = c_; A1 = nullptr; pmSplit = 1 << 30; sAn = 0; sBg = 0; gshift = 0; anshift = 0; }
  __device__ __forceinline__ bool next(int i, GUnit& u) const {
    const int Lx = i * G + c; if (Lx >= nwg) return false;
    int wgid = Lx; { const int q = nwg / NXCD, r = nwg % NXCD, xcd = wgid % NXCD, off = wgid / NXCD; wgid = (xcd < r ? xcd * (q + 1) : r * (q + 1) + (xcd - r) * q) + off; }
    const int nig = WGM * nN, gid = wgid / nig, fm = gid * WGM, gsz = (nM - fm) < WGM ? (nM - fm) : WGM;
    u.pm = fm + ((wgid % nig) % gsz); u.pn = (wgid % nig) / gsz;
    u.A = (u.pm < pmSplit ? A0 + (size_t)u.pm * sAm : A1 + (size_t)(u.pm - pmSplit) * sAm) + (size_t)(u.pn >> anshift) * sAn;
    u.B = B0 + (size_t)u.pn * sBn + (size_t)(u.pm >> gshift) * sBg;
    return true;
  }
};

typedef int v8i __attribute__((ext_vector_type(8)));
__device__ __forceinline__ v8i cat8(bf16x8 a, bf16x8 b) { union { bf16x8 h[2]; v8i v; } u; u.h[0] = a; u.h[1] = b; return u.v; }
template <class Epi, bool FP8 = false, int BD = 0>
__device__ __forceinline__ void gemm_phase(LAS unsigned char* lds, const int K, const int lda, const int ldb, const Sched& S, const Epi& E) {
  int tid = threadIdx.x; asm volatile("" : "+v"(tid));
  const int wid = __builtin_amdgcn_readfirstlane(tid >> 6), lane = tid & 63, wr = wid >> 2, wc = wid & 3, fr = lane & 15, fq = lane >> 4;
  const int nt = K / BK;
  unsigned voffA, voffB;
  { int R, C; stage_rc(tid * 16, R, C); const int Rb = (R & ~31) + perm32(R & 31); voffA = (unsigned)(R * lda + C) * 2u; voffB = (unsigned)(Rb * ldb + C) * 2u; }
  const size_t p2A = (size_t)64 * lda * 2, p2B = (size_t)64 * ldb * 2;
  const size_t kstep = (size_t)(BK * 2);
  const size_t hstepA = (size_t)HALF * lda * 2, hstepB = (size_t)HALF * ldb * 2;
  const unsigned ldsw = (unsigned)wid * 1024u;
  const int aoff = lds_byte(wr * 64 + fr, fq * 8), boff = lds_byte(wc * 32 + fr, fq * 8);
#define G8_SA(b, h) (((b) * 2 + (h)) * HTB)
#define G8_SB(b, h) ((4 + (b) * 2 + (h)) * HTB)
#define G8_STAGE(bufoff, gbase, NM) do { _Pragma("unroll") for (int _i = 0; _i < 2; ++_i) { \
    const char* _b = (const char*)(gbase) + (_i ? p2##NM : (size_t)0); asm volatile("" : "+s"(_b));     \
    __builtin_amdgcn_global_load_lds((const unsigned*)(_b + voff##NM), (LAS unsigned*)(lds + (bufoff) + ldsw + _i * 8192), 16, 0, 0); } } while (0)
#define G8_LDA(dst, b, h) do { _Pragma("unroll") for (int m = 0; m < 4; ++m) { \
    if constexpr (FP8) dst##8[m] = cat8(*(const LAS bf16x8*)(lds + G8_SA(b, h) + aoff + m * 2048), *(const LAS bf16x8*)(lds + G8_SA(b, h) + aoff + m * 2048 + 1024)); \
    else { _Pragma("unroll") for (int k = 0; k < 2; ++k) dst[m][k] = *(const LAS bf16x8*)(lds + G8_SA(b, h) + aoff + m * 2048 + k * 1024); } } } while (0)
#define G8_LDB(dst, b, h) do { _Pragma("unroll") for (int n = 0; n < 2; ++n) { \
    if constexpr (FP8) dst##8[n] = cat8(*(const LAS bf16x8*)(lds + G8_SB(b, h) + boff + n * 2048), *(const LAS bf16x8*)(lds + G8_SB(b, h) + boff + n * 2048 + 1024)); \
    else { _Pragma("unroll") for (int k = 0; k < 2; ++k) dst[n][k] = *(const LAS bf16x8*)(lds + G8_SB(b, h) + boff + n * 2048 + k * 1024); } } } while (0)
#define G8_MMA(ai, bj, At, Bt) do { __builtin_amdgcn_s_setprio(1); _Pragma("unroll") for (int m = 0; m < 4; ++m) _Pragma("unroll") for (int n = 0; n < 2; ++n) { \
    if constexpr (FP8) acc[ai][bj][m][n] = __builtin_amdgcn_mfma_scale_f32_16x16x128_f8f6f4(Bt##8[n], At##8[m], acc[ai][bj][m][n], 0, 0, 0, 0, 0, 0); \
    else { _Pragma("unroll") for (int k = 0; k < 2; ++k) acc[ai][bj][m][n] = __builtin_amdgcn_mfma_f32_16x16x32_bf16(Bt[n][k], At[m][k], acc[ai][bj][m][n], 0, 0, 0); } } \
    __builtin_amdgcn_s_setprio(0); } while (0)
#define G8_WAIT_V(n) asm volatile("s_waitcnt vmcnt(" #n ")" ::: "memory")
#define G8_WAIT_L(n) asm volatile("s_waitcnt lgkmcnt(" #n ")" ::: "memory")
#define G8_BAR __builtin_amdgcn_s_barrier()
#define G8_SCHED __builtin_amdgcn_sched_barrier(0)
  GUnit cur, nxt; int ui = 0;
  if (!S.next(0, cur)) return;
  f32x4 acc[2][2][4][2];
#pragma unroll
  for (int a = 0; a < 2; ++a)
#pragma unroll
    for (int b = 0; b < 2; ++b)
#pragma unroll
      for (int m = 0; m < 4; ++m)
#pragma unroll
        for (int n = 0; n < 2; ++n) acc[a][b][m][n] = (f32x4){0.f, 0.f, 0.f, 0.f};
  bf16x8 At[4][2], B0[2][2], B1[2][2];
  v8i At8[4], B08[2], B18[2];
  const char* cA = cur.A; const char* cB = cur.B;
  G8_STAGE(G8_SB(0, 0), cB, B); G8_STAGE(G8_SB(0, 1), cB + hstepB, B); G8_STAGE(G8_SA(0, 0), cA, A); G8_STAGE(G8_SA(0, 1), cA + hstepA, A);
  if (wr == 1) G8_BAR;
  G8_WAIT_V(2); G8_BAR;
  G8_STAGE(G8_SB(1, 0), cB + kstep, B); G8_STAGE(G8_SA(1, 0), cA + kstep, A); G8_STAGE(G8_SB(1, 1), cB + hstepB + kstep, B);
  G8_WAIT_V(6); G8_BAR;
  for (;;) {
    const bool has_next = S.next(ui + 1, nxt);
    const char* nA = has_next ? nxt.A : cA; const char* nB = has_next ? nxt.B : cB;
    for (int t = 0; t < nt; t += 2) {
      const bool last = (t == nt - 2);
      const char* a1 = cA + (size_t)(t + 1) * kstep + hstepA;
      const char* a2 = last ? nA : cA + (size_t)(t + 2) * kstep; const char* b2 = last ? nB : cB + (size_t)(t + 2) * kstep;
      const char* a3 = a2 + kstep; const char* b3 = b2 + kstep;
      asm volatile("" : "+s"(a1), "+s"(a2), "+s"(b2), "+s"(a3), "+s"(b3));
      G8_LDB(B0, 0, 0); G8_LDB(B1, 0, 1); G8_SCHED; G8_LDA(At, 0, 0); G8_STAGE(G8_SA(1, 1), a1, A);
      const bool d0a = (BD == 0) || (BD == 1 && t < (nt >> 1)) || (BD == 2 && !(cur.pn & 1));
      const bool d1a = (BD == 0) || (BD == 1 && t >= (nt >> 1)) || (BD == 2 && !(cur.pn & 1));
      const bool d0b = (BD == 0) || (BD == 1 && t < (nt >> 1)) || (BD == 2 && (cur.pn & 1));
      const bool d1b = (BD == 0) || (BD == 1 && t >= (nt >> 1)) || (BD == 2 && (cur.pn & 1));
      G8_WAIT_V(8); G8_WAIT_L(0); G8_BAR; if (d0a) G8_MMA(0, 0, At, B0); if (d1a) G8_MMA(0, 1, At, B1); G8_BAR; G8_SCHED;
      G8_LDA(At, 0, 1); G8_STAGE(G8_SB(0, 0), b2, B); G8_STAGE(G8_SB(0, 1), b2 + hstepB, B); G8_STAGE(G8_SA(0, 0), a2, A);
      G8_WAIT_V(8); G8_WAIT_L(0); G8_BAR; if (d0a) G8_MMA(1, 0, At, B0); if (d1a) G8_MMA(1, 1, At, B1); G8_BAR; G8_SCHED;
      G8_LDB(B0, 1, 0); G8_LDB(B1, 1, 1); G8_SCHED; G8_LDA(At, 1, 0); G8_STAGE(G8_SA(0, 1), a2 + hstepA, A);
      G8_WAIT_V(8); G8_WAIT_L(0); G8_BAR; if (d0b) G8_MMA(0, 0, At, B0); if (d1b) G8_MMA(0, 1, At, B1); G8_BAR; G8_SCHED;
      G8_LDA(At, 1, 1); G8_STAGE(G8_SB(1, 0), b3, B); G8_STAGE(G8_SB(1, 1), b3 + hstepB, B); G8_STAGE(G8_SA(1, 0), a3, A);
      G8_WAIT_V(8); G8_WAIT_L(0); G8_BAR; if (d0b) G8_MMA(1, 0, At, B0); if (d1b) G8_MMA(1, 1, At, B1); G8_BAR; G8_SCHED;
    }
    if (wr == 0) G8_BAR;
    {
      int t2 = threadIdx.x; asm volatile("" : "+v"(t2));
      const int w2 = __builtin_amdgcn_readfirstlane(t2 >> 6), l2 = t2 & 63;
      E(acc, cur, w2 >> 2, w2 & 3, l2 & 15, l2 >> 4); }
    if (!has_next) break;
#pragma unroll
    for (int a = 0; a < 2; ++a)
#pragma unroll
      for (int b = 0; b < 2; ++b)
#pragma unroll
        for (int m = 0; m < 4; ++m)
#pragma unroll
          for (int n = 0; n < 2; ++n) acc[a][b][m][n] = (f32x4){0.f, 0.f, 0.f, 0.f};
    cur = nxt; cA = nA; cB = nB; ++ui;
    if (wr == 1) G8_BAR;
  }
  G8_WAIT_V(0);
  G8_BAR;
#undef G8_SA
#undef G8_SB
#undef G8_STAGE
#undef G8_LDA
#undef G8_LDB
#undef G8_MMA
#undef G8_WAIT_V
#undef G8_WAIT_L
#undef G8_BAR
#undef G8_SCHED
}

typedef f32x4 Acc[2][2][4][2];

struct EpiProjA {
  const float* ss0; bf16_t* q; bf16_t* z; float* ckv; bf16_t* qidx; bf16_t* kidx; float* widx; const float* kg; int pnoff; float osc;
  __device__ __forceinline__ void operator()(const Acc& acc, const GUnit& u, int wr, int wc, int fr, int fq) const {
    const int row0 = u.pm * 256 + wr * 64 + fr, pn = u.pn + pnoff;
#pragma unroll
    for (int ai = 0; ai < 2; ++ai)
#pragma unroll
      for (int m = 0; m < 4; ++m) {
        const int row = row0 + ai * 128 + m * 16;
        const float rs = rsqrtf(ss0[row] * (1.f / 2048.f) + EPS) * osc;
        if (pn < 32) {
          unsigned char* base = (unsigned char*)(pn < 16 ? q : z) + (size_t)row * 4096 + (pn & 15) * 256 + wc * 32 + 8 * fq;
#pragma unroll
          for (int bj = 0; bj < 2; ++bj) { const f32x4 a = acc[ai][bj][m][0] * rs, b = acc[ai][bj][m][1] * rs; u32x2 w;
            w[0] = __builtin_amdgcn_cvt_pk_fp8_f32(a[0], a[1], 0, false); w[0] = __builtin_amdgcn_cvt_pk_fp8_f32(a[2], a[3], w[0], true);
            w[1] = __builtin_amdgcn_cvt_pk_fp8_f32(b[0], b[1], 0, false); w[1] = __builtin_amdgcn_cvt_pk_fp8_f32(b[2], b[3], w[1], true);
            *(u32x2*)(base + bj * 128) = w; }
        } else if (pn == 32) {
          float* base = ckv + (size_t)row * 256 + wc * 32 + 8 * fq;
#pragma unroll
          for (int bj = 0; bj < 2; ++bj) { *(f32x4*)(base + bj * 128) = acc[ai][bj][m][0] * rs; *(f32x4*)(base + bj * 128 + 4) = acc[ai][bj][m][1] * rs; }
        } else if (pn < 37) {
          bf16_t* base = qidx + (size_t)row * 1024 + (pn - 33) * 256 + wc * 32 + 8 * fq;
#pragma unroll
          for (int bj = 0; bj < 2; ++bj) *(u32x4*)(base + bj * 128) = pack8(acc[ai][bj][m][0] * rs, acc[ai][bj][m][1] * rs);
        } else {
          if (wc == 0) {
            f32x4 v[2][2]; float s = 0.f;
#pragma unroll
            for (int bj = 0; bj < 2; ++bj)
#pragma unroll
              for (int n = 0; n < 2; ++n) { v[bj][n] = acc[ai][bj][m][n] * rs; s += v[bj][n][0] * v[bj][n][0] + v[bj][n][1] * v[bj][n][1] + v[bj][n][2] * v[bj][n][2] + v[bj][n][3] * v[bj][n][3]; }
            s = psum32(psum16(s));
            const float kr = rsqrtf(s * (1.f / 64.f) + EPS);
#pragma unroll
            for (int bj = 0; bj < 2; ++bj) {
              const f32x4 g0 = *(const f32x4*)(kg + 32 * bj + 8 * fq), g1 = *(const f32x4*)(kg + 32 * bj + 8 * fq + 4);
              *(u32x4*)(kidx + ((size_t)(row >> 5) * 4 + 2 * bj + (fq >> 1)) * 512 + ((fq & 1) * 32 + (row & 31)) * 8) = pack8(v[bj][0] * kr * g0, v[bj][1] * kr * g1);
            }
          } else if (wc == 1 && fq < 2) {
            float* base = widx + (size_t)row * 16 + 8 * fq;
            *(f32x4*)(base) = acc[ai][0][m][0] * (rs * 0.25f); *(f32x4*)(base + 4) = acc[ai][0][m][1] * (rs * 0.25f);
          }
        }
      }
  }
};

struct EpiBf16 {
  bf16_t* O0; bf16_t* O1; int nsplit; int ld; const float* ss;
  __device__ __forceinline__ void operator()(const Acc& acc, const GUnit& u, int wr, int wc, int fr, int fq) const {
    const int row0 = u.pm * 256 + wr * 64 + fr;
    bf16_t* ob = (u.pn < nsplit ? O0 + (size_t)u.pn * 256 : O1 + (size_t)(u.pn - nsplit) * 256) + wc * 32 + 8 * fq;
#pragma unroll
    for (int ai = 0; ai < 2; ++ai)
#pragma unroll
      for (int m = 0; m < 4; ++m) {
        const int row = row0 + ai * 128 + m * 16;
        const float rs = ss ? rsqrtf(ss[row] * (1.f / 2048.f) + EPS) : 1.f;
#pragma unroll
        for (int bj = 0; bj < 2; ++bj) *(u32x4*)(ob + (size_t)row * ld + bj * 128) = pack8(acc[ai][bj][m][0] * rs, acc[ai][bj][m][1] * rs);
      }
  }
};

struct EpiQlat {
  unsigned char* Q0; float osc;
  __device__ __forceinline__ void operator()(const Acc& acc, const GUnit& u, int wr, int wc, int fr, int fq) const {
    const int row0 = u.pm * 256 + wr * 64 + fr;
    unsigned char* ob = Q0 + (size_t)u.pn * 256 + wc * 32 + 8 * fq;
#pragma unroll
    for (int ai = 0; ai < 2; ++ai)
#pragma unroll
      for (int m = 0; m < 4; ++m) {
        const int row = row0 + ai * 128 + m * 16;
#pragma unroll
        for (int bj = 0; bj < 2; ++bj) { const f32x4 a = acc[ai][bj][m][0] * osc, b = acc[ai][bj][m][1] * osc; u32x2 w;
          w[0] = __builtin_amdgcn_cvt_pk_fp8_f32(a[0], a[1], 0, false); w[0] = __builtin_amdgcn_cvt_pk_fp8_f32(a[2], a[3], w[0], true);
          w[1] = __builtin_amdgcn_cvt_pk_fp8_f32(b[0], b[1], 0, false); w[1] = __builtin_amdgcn_cvt_pk_fp8_f32(b[2], b[3], w[1], true);
          *(u32x2*)(ob + (size_t)row * 8192 + bj * 128) = w; }
      }
  }
};

struct EpiGate {
  unsigned char* Y; const unsigned char* Z; float osc;
  __device__ __forceinline__ void operator()(const Acc& acc, const GUnit& u, int wr, int wc, int fr, int fq) const {
    const int row0 = u.pm * 256 + wr * 64 + fr; const int col0 = u.pn * 256 + wc * 32 + 8 * fq;
#pragma unroll
    for (int ai = 0; ai < 2; ++ai)
#pragma unroll
      for (int m = 0; m < 4; ++m) {
        const size_t off = (size_t)(row0 + ai * 128 + m * 16) * 4096 + col0;
#pragma unroll
        for (int bj = 0; bj < 2; ++bj) {
          const u32x2 zw = *(const u32x2*)(Z + off + bj * 128);
          typedef float f32x2v __attribute__((ext_vector_type(2)));
          const f32x2v z0 = __builtin_amdgcn_cvt_pk_f32_fp8(zw[0], false), z1 = __builtin_amdgcn_cvt_pk_f32_fp8(zw[0], true), z2 = __builtin_amdgcn_cvt_pk_f32_fp8(zw[1], false), z3 = __builtin_amdgcn_cvt_pk_f32_fp8(zw[1], true);
          f32x4 a = acc[ai][bj][m][0] * osc, b = acc[ai][bj][m][1] * osc;
          a[0] *= silu_fast(z0[0]); a[1] *= silu_fast(z0[1]); a[2] *= silu_fast(z1[0]); a[3] *= silu_fast(z1[1]);
          b[0] *= silu_fast(z2[0]); b[1] *= silu_fast(z2[1]); b[2] *= silu_fast(z3[0]); b[3] *= silu_fast(z3[1]);
          u32x2 w; w[0] = __builtin_amdgcn_cvt_pk_fp8_f32(a[0], a[1], 0, false); w[0] = __builtin_amdgcn_cvt_pk_fp8_f32(a[2], a[3], w[0], true);
          w[1] = __builtin_amdgcn_cvt_pk_fp8_f32(b[0], b[1], 0, false); w[1] = __builtin_amdgcn_cvt_pk_fp8_f32(b[2], b[3], w[1], true);
          *(u32x2*)(Y + off + bj * 128) = w;
        }
      }
  }
};

struct EpiRes {
  const float* R; const bf16_t* RB; int ldrb; float* H; bf16_t* HB; int ldhb; float* ss; float osc;
  __device__ __forceinline__ void operator()(const Acc& acc, const GUnit& u, int wr, int wc, int fr, int fq) const {
    const int row0 = u.pm * 256 + wr * 64 + fr; const int col0 = u.pn * 256 + wc * 32 + 8 * fq;
#pragma unroll
    for (int ai = 0; ai < 2; ++ai)
#pragma unroll
      for (int m = 0; m < 4; ++m) {
        const int row = row0 + ai * 128 + m * 16; const size_t off = (size_t)row * 2048 + col0; float s = 0.f;
#pragma unroll
        for (int bj = 0; bj < 2; ++bj) {
          f32x4 r0, r1;
          if (R) { r0 = *(const f32x4*)(R + off + bj * 128); r1 = *(const f32x4*)(R + off + bj * 128 + 4); }
          else { const u32x4 rw = *(const u32x4*)(RB + (size_t)row * ldrb + col0 + bj * 128);
            r0 = (f32x4){bflo(rw[0]), bfhi(rw[0]), bflo(rw[1]), bfhi(rw[1])}; r1 = (f32x4){bflo(rw[2]), bfhi(rw[2]), bflo(rw[3]), bfhi(rw[3])}; }
          const f32x4 h0 = r0 + acc[ai][bj][m][0] * osc, h1 = r1 + acc[ai][bj][m][1] * osc;
          if (H) { *(f32x4*)(H + off + bj * 128) = h0; *(f32x4*)(H + off + bj * 128 + 4) = h1; }
          if (HB) *(u32x4*)(HB + (size_t)row * ldhb + col0 + bj * 128) = pack8(h0, h1);
          s += h0[0] * h0[0] + h0[1] * h0[1] + h0[2] * h0[2] + h0[3] * h0[3] + h1[0] * h1[0] + h1[1] * h1[1] + h1[2] * h1[2] + h1[3] * h1[3];
        }
        s = psum32(psum16(s));
        if (fq == 0) atomicAdd(ss + row, s);
      }
  }
};
}

struct CmA { __device__ __forceinline__ int operator()(int n) const {
  if (n < 4096) return n;
  if (n < 8192) return 5456 + (n - 4096);
  if (n < 8448) return 4096 + (n - 8192);
  if (n < 9472) return 4352 + (n - 8448);
  const int c = n - 9472;
  if (c < 32) return 5376 + c;
  if (c < 48) return 5440 + (c - 32);
  if (c >= 128 && c < 160) return 5376 + 32 + (c - 128);
  return -1; } };
struct CmAI { __device__ __forceinline__ int operator()(int n) const { return CmA{}(n + 8192); } };
struct CmOff { int off; __device__ __forceinline__ int operator()(int n) const { return n + off; } };

template <class CM, bool FP8 = false>
__device__ __forceinline__ void tconv_tile(bf16_t* dst, int ldD, const float* src, int ldS, int kt, int np, const float* gk, CM cm, float* tl, int tid, float wsc = 1.f) {
  {
    { const int c = tid & 63, r = tid >> 6; const int sc0 = cm(np * 128 + c), sc1 = cm(np * 128 + 64 + c);
      float v0[8], v1[8];
#pragma unroll
      for (int pass = 0; pass < 8; ++pass) { const int k = kt * 64 + pass * 8 + r; const float g = (gk ? gk[k] : 1.f) * wsc;
        v0[pass] = (sc0 >= 0) ? src[(size_t)k * ldS + sc0] * g : 0.f; v1[pass] = (sc1 >= 0) ? src[(size_t)k * ldS + sc1] * g : 0.f; }
#pragma unroll
      for (int pass = 0; pass < 8; ++pass) { tl[(pass * 8 + r) * 129 + c] = v0[pass]; tl[(pass * 8 + r) * 129 + 64 + c] = v1[pass]; } }
    __syncthreads();
#pragma unroll
    for (int hf = 0; hf < 2; ++hf) { const int nl = hf * 64 + (tid >> 3), kc = tid & 7; float v[8];
#pragma unroll
      for (int j = 0; j < 8; ++j) v[j] = tl[(kc * 8 + j) * 129 + nl];
      if constexpr (FP8) {
        u32x2 w; w[0] = __builtin_amdgcn_cvt_pk_fp8_f32(v[0], v[1], 0, false); w[0] = __builtin_amdgcn_cvt_pk_fp8_f32(v[2], v[3], w[0], true);
        w[1] = __builtin_amdgcn_cvt_pk_fp8_f32(v[4], v[5], 0, false); w[1] = __builtin_amdgcn_cvt_pk_fp8_f32(v[6], v[7], w[1], true);
        *(u32x2*)((unsigned char*)dst + (size_t)(np * 128 + nl) * ldD + kt * 64 + kc * 8) = w;
      } else {
      u32x4 w; w[0] = cvt_pk_bf16(v[0], v[1]); w[1] = cvt_pk_bf16(v[2], v[3]); w[2] = cvt_pk_bf16(v[4], v[5]); w[3] = cvt_pk_bf16(v[6], v[7]);
      *(u32x4*)(dst + (size_t)(np * 128 + nl) * ldD + kt * 64 + kc * 8) = w; } }
    __syncthreads();
  }
}
template <class CM, bool FP8 = false>
__device__ __forceinline__ void tconv(bf16_t* dst, int ldD, const float* src, int ldS, int Ktiles, int Ntiles, const float* gk, CM cm, float* tl, int bid, int nb, float wsc = 1.f) {
  int tid = threadIdx.x; asm volatile("" : "+v"(tid));
  const int Np = Ntiles >> 1;
  for (int tile = bid; tile < Ktiles * Np; tile += nb) tconv_tile<CM, FP8>(dst, ldD, src, ldS, tile / Np, tile % Np, gk, cm, tl, tid, wsc);
}

__device__ __forceinline__ void p0_prep(const Params& p, unsigned char* lds, int bid, int nb) {
  int tid = threadIdx.x; asm volatile("" : "+v"(tid));
  const int lane = tid & 63, wid = tid >> 6;
  float* tl = (float*)lds;
  unsigned char* ws = p.ws;
  { bf16_t* xb = (bf16_t*)(ws + OFF_QL0); unsigned char* xq = ws + OFF_XQ; float* ss0 = (float*)(ws + OFF_SS);
    for (int row = bid * 8 + wid; row < T; row += nb * 8) {
      const f32x4* src = (const f32x4*)(p.x + (size_t)row * D); float s = 0.f;
#pragma unroll
      for (int j = 0; j < 8; ++j) { const f32x4 v = src[lane + 64 * j]; s += v[0] * v[0] + v[1] * v[1] + v[2] * v[2] + v[3] * v[3];
        u32x2 o; o[0] = cvt_pk_bf16(v[0], v[1]); o[1] = cvt_pk_bf16(v[2], v[3]); *(u32x2*)(xb + (size_t)row * D + (lane + 64 * j) * 4) = o;
        unsigned q8 = __builtin_amdgcn_cvt_pk_fp8_f32(v[0], v[1], 0, false); q8 = __builtin_amdgcn_cvt_pk_fp8_f32(v[2], v[3], q8, true); *(unsigned*)(xq + (size_t)row * D + (lane + 64 * j) * 4) = q8; }
      s = wave_sum(s, lane); if (lane == 0) ss0[row] = s;
    }
    for (int i = bid * 512 + tid; i < 2 * T; i += nb * 512) ss0[T + i] = 0.f;
    { float* sm = (float*)(ws + OFF_SMALL);
      for (int i = bid * 512 + tid; i < SM_TOTAL; i += nb * 512) {
        float v;
        if (i < SM_KVN) v = p.kidx_norm[i]; else if (i < SM_RELB) v = p.kv_norm[i - SM_KVN]; else if (i < SM_BGRP) v = p.rel_bias[i - SM_RELB];
        else if (i < SM_SCALE) v = p.b_grp[i - SM_BGRP]; else if (i < SM_FINAL) v = p.scale_b[i - SM_SCALE]; else v = p.final_norm[i - SM_FINAL];
        sm[i] = v; } } }
  tconv<CmA, true>((bf16_t*)(ws + OFF_WA), 2048, p.w_in_a, 9552, 32, 128, p.norm_a, CmA{}, tl, bid, nb, 64.f);
  tconv((bf16_t*)(ws + OFF_WAI), 2048, p.w_in_a, 9552, 32, 24, p.norm_a, CmAI{}, tl, bid, nb);
  tconv<CmOff, true>((bf16_t*)(ws + OFF_WOUTA), 4096, p.w_out_a, 2048, 64, 32, nullptr, CmOff{0}, tl, bid, nb, 64.f);
  tconv((bf16_t*)(ws + OFF_WB) + (size_t)4096 * LDWB, LDWB, p.w_in_b, 8192, 32, 64, p.norm_b, CmOff{4096}, tl, bid, nb);
  for (int it = bid; it < 512; it += nb) { const int g = it >> 7, rem = it & 127;
    tconv_tile((bf16_t*)(ws + OFF_WG) + (size_t)g * 1048576, 1024, p.w_grp + (size_t)g * 1048576, 1024, rem >> 3, rem & 7, nullptr, CmOff{0}, tl, tid); }
  tconv((bf16_t*)(ws + OFF_WOUTB), 4096, p.w_out_b, 2048, 64, 32, nullptr, CmOff{0}, tl, bid, nb);
  for (int it = bid; it < 128; it += nb) {
    const int h = it >> 2, pair = h >> 1, hh = h & 1;
    tconv_tile<CmOff, true>((bf16_t*)(ws + OFF_WUV + (size_t)pair * 131072 + (size_t)hh * 128 * 512 + hh * 256), 512, p.w_uv + h * 128, 4096, it & 3, 0, nullptr, CmOff{0}, tl, tid, 16.f);
  }
  {
    unsigned char* wv = ws + OFF_WUV;
    for (int i = bid * 512 + tid; i < 32 * 128 * 16; i += nb * 512) {
      const int piece = i & 15, r = (i >> 4) & 127, ph = i >> 11; const int pair = ph >> 1, hh = ph & 1;
      *(u32x4*)(wv + (size_t)pair * 131072 + (size_t)(hh * 128 + r) * 512 + (1 - hh) * 256 + piece * 16) = (u32x4){0u, 0u, 0u, 0u};
    } }
  {
    bf16_t* wu = (bf16_t*)(ws + OFF_WU);
    for (int i = bid * 512 + tid; i < 4 * 2048 * 256; i += nb * 512) {
      const int p4 = i & 255, k = (i >> 8) & 2047, g = i >> 19;
      const f32x4 v = *(const f32x4*)(p.w_in_b + (size_t)k * 8192 + g * 1024 + p4 * 4) * p.norm_b[k];
      u32x2 o; o[0] = cvt_pk_bf16(v[0], v[1]); o[1] = cvt_pk_bf16(v[2], v[3]); *(u32x2*)(wu + (size_t)g * 2097152 + (size_t)k * 1024 + p4 * 4) = o;
    } }
  {
    unsigned char* wk = ws + OFF_WUK;
    for (int i = bid * 512 + tid; i < 16 * 512 * 64; i += nb * 512) {
      const int k4 = i & 63, n = (i >> 6) & 511, pr = i >> 15; const int hh = n >> 8, c = n & 255;
      unsigned w = 0u;
      if ((k4 >> 5) == hh) { const f32x4 v = *(const f32x4*)(p.w_uk + (size_t)c * 4096 + (2 * pr + hh) * 128 + (k4 & 31) * 4) * 16.f;
        w = __builtin_amdgcn_cvt_pk_fp8_f32(v[0], v[1], 0, false); w = __builtin_amdgcn_cvt_pk_fp8_f32(v[2], v[3], w, true); }
      *(unsigned*)(wk + (size_t)pr * 131072 + (size_t)n * 256 + k4 * 4) = w;
    } }
}

__device__ __forceinline__ void p3_ckvnorm(const Params& p, int bid, int nb) {
  int tid = threadIdx.x; asm volatile("" : "+v"(tid));
  const int lane = tid & 63, wid = tid >> 6;
  const float* cr = (const float*)(p.ws + OFF_CKVR); bf16_t* cn = (bf16_t*)(p.ws + OFF_CKVN);
  const f32x4 g = *(const f32x4*)((const float*)(p.ws + OFF_SMALL) + SM_KVN + lane * 4);
  for (int row = bid * 8 + wid; row < T; row += nb * 8) {
    const f32x4 v = *(const f32x4*)(cr + (size_t)row * 256 + lane * 4);
    float s = v[0] * v[0] + v[1] * v[1] + v[2] * v[2] + v[3] * v[3]; s = wave_sum(s, lane);
    const float r = rsqrtf(s * (1.f / 256.f) + EPS);
    u32x2 o; o[0] = cvt_pk_bf16(v[0] * r * g[0], v[1] * r * g[1]); o[1] = cvt_pk_bf16(v[2] * r * g[2], v[3] * r * g[3]);
    *(u32x2*)(cn + (size_t)row * 256 + lane * 4) = o;
  }
}

__device__ __forceinline__ void p3_indexer(const Params& p, unsigned char* lds, int bid, int nb, int rep_sc, int rep_sel) {
  float* sc = (float*)lds;
  const bf16_t* qidx = (const bf16_t*)(p.ws + OFF_QIDX); const bf16_t* kidx = (const bf16_t*)(p.ws + OFF_KIDX); const float* widx = (const float*)(p.ws + OFF_WIDX);
  unsigned short* idxo = (unsigned short*)(p.ws + OFF_IDX);
  int tid = threadIdx.x; asm volatile("" : "+v"(tid));
  const int lane = tid & 63, wid = tid >> 6, h = lane >> 5, l31 = lane & 31;
  for (int round = 0; round * nb + bid < T / 16; ++round) {
    const int item = round * nb + bid;
    const int b = item & 15; int tile = item >> 4; { const int r16 = tile >> 4, j = tile & 15; tile = r16 * 16 + ((r16 & 1) ? 15 - j : j); }
    const int t0 = tile * 16;
    if (t0 < 256) {
      const int tok = tid >> 5, j0 = (tid & 31) * 8, t = t0 + tok;
      unsigned short v[8];
#pragma unroll
      for (int j = 0; j < 8; ++j) v[j] = (unsigned short)((j0 + j <= t) ? (j0 + j) : 0);
      u32x4 w; w[0] = v[0] | ((unsigned)v[1] << 16); w[1] = v[2] | ((unsigned)v[3] << 16); w[2] = v[4] | ((unsigned)v[5] << 16); w[3] = v[6] | ((unsigned)v[7] << 16);
      *(u32x4*)(idxo + (size_t)(b * L + t) * 256 + j0) = w;
      continue;
    }
    for (int rsc = 0; rsc < rep_sc; ++rsc) {
      const int tok = l31 >> 4, head = l31 & 15;
      const bf16_t* arow = qidx + (size_t)(b * L + t0 + 2 * wid + tok) * 1024 + head * 64 + 8 * h;
      bf16x8 aq[4];
#pragma unroll
      for (int ks = 0; ks < 4; ++ks) aq[ks] = *(const bf16x8*)(arow + 16 * ks);
      float wv[16];
#pragma unroll
      for (int tk = 0; tk < 2; ++tk) {
        const float* wp = widx + (size_t)(b * L + t0 + 2 * wid + tk) * 16 + 4 * h;
        const f32x4 w0 = *(const f32x4*)(wp), w1 = *(const f32x4*)(wp + 8);
#pragma unroll
        for (int i = 0; i < 4; ++i) { wv[tk * 8 + i] = w0[i] * 0.125f; wv[tk * 8 + 4 + i] = w1[i] * 0.125f; }
      }
      const unsigned char* kb = (const unsigned char*)(kidx + (size_t)b * 64 * 2048) + tid * 16;
      LAS unsigned char* stgb = (LAS unsigned char*)lds + 131072;
      const int nkt = ((t0 + 15) >> 5) + 1, ngr = (nkt + 1) >> 1;
      u32x4 sv = *(const u32x4*)(kb);
      *(LAS u32x4*)(stgb + tid * 16) = sv;
      if (ngr > 1) sv = *(const u32x4*)(kb + 8192);
      __syncthreads();
      for (int gr = 0; gr < ngr; ++gr) {
        if (gr + 1 < ngr) *(LAS u32x4*)(stgb + ((gr + 1) & 1) * 8192 + tid * 16) = sv;
        if (gr + 2 < ngr) sv = *(const u32x4*)(kb + (size_t)(gr + 2) * 8192);
        const LAS unsigned char* bb = stgb + (gr & 1) * 8192 + lane * 16;
#pragma unroll
        for (int q = 0; q < 2; ++q) {
          f32x16 acc;
#pragma unroll
          for (int i = 0; i < 16; ++i) acc[i] = 0.f;
#pragma unroll
          for (int ks = 0; ks < 4; ++ks) { const bf16x8 bfr = *(const LAS bf16x8*)(bb + q * 4096 + ks * 1024); acc = __builtin_amdgcn_mfma_f32_32x32x16_bf16(aq[ks], bfr, acc, 0, 0, 0); }
          float s0 = 0.f, s1 = 0.f;
#pragma unroll
          for (int i = 0; i < 8; ++i) { s0 += wv[i] * relu_i(acc[i]); s1 += wv[8 + i] * relu_i(acc[8 + i]); }
          s0 = psum32(s0); s1 = psum32(s1);
          sc[(2 * wid + h) * 2048 + 32 * (2 * gr + q) + l31] = h ? s1 : s0;
        }
        __syncthreads();
      }
    }
    __syncthreads();
    LAS unsigned* hist = (LAS unsigned*)((LAS unsigned char*)lds + 131072) + wid * 256;
    LAS unsigned* cand = (LAS unsigned*)((LAS unsigned char*)lds + 131072 + 8192) + wid * 128;
    for (int rsel = 0; rsel < rep_sel; ++rsel)
    for (int qq = 0; qq < 2; ++qq) {
      const int qi = 2 * wid + qq, t = t0 + qi;
      float v[32];
#pragma unroll
      for (int j = 0; j < 32; ++j) v[j] = sc[qi * 2048 + lane + 64 * j];
      float mn = 3.0e38f, mx = -3.0e38f;
#pragma unroll
      for (int j = 0; j < 32; ++j) { const bool valid = (lane + 64 * j) <= t; mn = valid ? fminf(mn, v[j]) : mn; mx = valid ? fmaxf(mx, v[j]) : mx; }
      mn = wave_min(mn); mx = wave_max(mx);
      const float scale = (mx > mn) ? 255.f / (mx - mn) : 0.f;
      *(LAS u32x4*)(hist + lane * 4) = (u32x4){0u, 0u, 0u, 0u};
      asm volatile("" ::: "memory");
#pragma unroll
      for (int j = 0; j < 32; ++j) { const bool valid = (lane + 64 * j) <= t; const int bin = min((int)((v[j] - mn) * scale), 255);
        if (valid) __hip_atomic_fetch_add(hist + bin, 1u, __ATOMIC_RELAXED, __HIP_MEMORY_SCOPE_WORKGROUP); }
      asm volatile("s_waitcnt lgkmcnt(0)" ::: "memory");
      const u32x4 h4 = *(const LAS u32x4*)(hist + lane * 4);
      const int tot = (int)(h4[0] + h4[1] + h4[2] + h4[3]);
      int px = tot;
      px += __builtin_amdgcn_update_dpp(0, px, 0x111, 0xf, 0xf, true); px += __builtin_amdgcn_update_dpp(0, px, 0x112, 0xf, 0xf, true);
      px += __builtin_amdgcn_update_dpp(0, px, 0x114, 0xf, 0xf, true); px += __builtin_amdgcn_update_dpp(0, px, 0x118, 0xf, 0xf, true);
      const int rt0 = __builtin_amdgcn_readlane(px, 15), rt1 = __builtin_amdgcn_readlane(px, 31), rt2 = __builtin_amdgcn_readlane(px, 47), rt3 = __builtin_amdgcn_readlane(px, 63);
      const int pre = px + (lane >= 16 ? rt0 : 0) + (lane >= 32 ? rt1 : 0) + (lane >= 48 ? rt2 : 0);
      const int suf = (rt0 + rt1 + rt2 + rt3) - pre + tot;
      const int S3 = suf - tot + (int)h4[3], S2 = S3 + (int)h4[2], S1 = S2 + (int)h4[1], S0 = S1 + (int)h4[0];
      const unsigned long long bm = __ballot(S0 >= 256);
      const int lstar = 63 - __clzll(bm);
      const int myB = S3 >= 256 ? 3 : (S2 >= 256 ? 2 : (S1 >= 256 ? 1 : 0));
      const int mySB = S3 >= 256 ? S3 : (S2 >= 256 ? S2 : (S1 >= 256 ? S1 : S0));
      const int myh = (int)(S3 >= 256 ? h4[3] : (S2 >= 256 ? h4[2] : (S1 >= 256 ? h4[1] : h4[0])));
      const int B = lstar * 4 + __builtin_amdgcn_readlane(myB, lstar);
      const int m = __builtin_amdgcn_readlane(myh, lstar);
      const int c_hi = __builtin_amdgcn_readlane(mySB, lstar) - m, need = 256 - c_hi;
      unsigned short* op = idxo + (size_t)(b * L + t) * 256;
      int base = 0, cbn = 0;
#pragma unroll
      for (int j = 0; j < 32; ++j) {
        const int e = lane + 64 * j; const bool valid = e <= t; const int bin = min((int)((v[j] - mn) * scale), 255);
        const bool hi = valid && bin > B, eq = valid && bin == B;
        const unsigned long long hm = __ballot(hi), em = __ballot(eq);
        const int pos = base + (int)__builtin_amdgcn_mbcnt_hi((unsigned)(hm >> 32), __builtin_amdgcn_mbcnt_lo((unsigned)hm, 0u));
        const int cpos = cbn + (int)__builtin_amdgcn_mbcnt_hi((unsigned)(em >> 32), __builtin_amdgcn_mbcnt_lo((unsigned)em, 0u));
        if (hi && pos < 256) op[pos] = (unsigned short)e;
        if (eq && cpos < 64) { const unsigned bits = __float_as_uint(v[j]); cand[2 * cpos] = bits ^ ((bits >> 31) ? 0xFFFFFFFFu : 0x80000000u); cand[2 * cpos + 1] = (unsigned)e; }
        base += __popcll(hm); cbn += __popcll(em);
      }
      if (m <= 64) {
        asm volatile("s_waitcnt lgkmcnt(0)" ::: "memory");
        const unsigned ck = (lane < m) ? cand[2 * lane] : 0u, ce = (lane < m) ? cand[2 * lane + 1] : 0xffffu;
        int rank = 0;
        for (int jj = 0; jj < m; ++jj) { const unsigned kj = __builtin_amdgcn_readlane(ck, jj), ej = __builtin_amdgcn_readlane(ce, jj); rank += (kj > ck || (kj == ck && ej < ce)) ? 1 : 0; }
        const bool selc = (lane < m) && (rank < need);
        const unsigned long long sm = __ballot(selc);
        const int pos = c_hi + (int)__builtin_amdgcn_mbcnt_hi((unsigned)(sm >> 32), __builtin_amdgcn_mbcnt_lo((unsigned)sm, 0u));
        if (selc && pos < 256) op[pos] = (unsigned short)ce;
      } else {
#define KEYOF(j) (((lane + 64 * (j)) <= t) ? (__float_as_uint(v[j]) ^ ((__float_as_uint(v[j]) >> 31) ? 0xFFFFFFFFu : 0x80000000u)) : 0u)
        unsigned prefix = 0u;
        for (int bit = 31; bit >= 0; --bit) {
          const unsigned cnd = prefix | (1u << bit); int cnt = 0;
#pragma unroll
          for (int j = 0; j < 32; ++j) cnt += __popcll(__ballot(KEYOF(j) >= cnd));
          if (cnt >= 256) prefix = cnd;
        }
        int cgt = 0;
#pragma unroll
        for (int j = 0; j < 32; ++j) cgt += __popcll(__ballot(KEYOF(j) > prefix));
        const int need2 = 256 - cgt; int base2 = 0, tb = 0;
#pragma unroll
        for (int j = 0; j < 32; ++j) {
          const unsigned uj = KEYOF(j); const bool gt = uj > prefix, eq = (uj == prefix);
          const unsigned long long eqm = __ballot(eq);
          const int trank = tb + (int)__builtin_amdgcn_mbcnt_hi((unsigned)(eqm >> 32), __builtin_amdgcn_mbcnt_lo((unsigned)eqm, 0u));
          const bool sel = gt || (eq && trank < need2);
          const unsigned long long sm = __ballot(sel);
          const int pos = base2 + (int)__builtin_amdgcn_mbcnt_hi((unsigned)(sm >> 32), __builtin_amdgcn_mbcnt_lo((unsigned)sm, 0u));
          if (sel && pos < 256) op[pos] = (unsigned short)(lane + 64 * j);
          base2 += __popcll(sm); tb += __popcll(eqm);
        }
#undef KEYOF
      }
    }
    __syncthreads();
  }
}

__device__ __forceinline__ void pair_sync(LAS unsigned* cnt, unsigned target, int lane) {
  asm volatile("" ::: "memory");
  if (lane == 0) __hip_atomic_fetch_add(cnt, 1u, __ATOMIC_RELAXED, __HIP_MEMORY_SCOPE_WORKGROUP);
  while (__hip_atomic_load(cnt, __ATOMIC_RELAXED, __HIP_MEMORY_SCOPE_WORKGROUP) < target) __builtin_amdgcn_s_sleep(1);
  asm volatile("" ::: "memory");
}
constexpr int CROW = 544;
constexpr int CTOK = 32 * CROW;
constexpr int CBUF = 4 * CTOK;
__device__ __forceinline__ void p4_attn(const Params& p, unsigned char* lds, int bid, int nb, bool dry) {
  LAS unsigned char* cbuf = (LAS unsigned char*)lds;
  LAS float* biasd = (LAS float*)((LAS unsigned char*)lds + 2 * CBUF);
  LAS unsigned short* idxs = (LAS unsigned short*)((LAS unsigned char*)lds + 2 * CBUF + 129 * 32 * 4);
  const bf16_t* ckvn = (const bf16_t*)(p.ws + OFF_CKVN); const unsigned short* idxg = (const unsigned short*)(p.ws + OFF_IDX);
  unsigned char* QL = p.ws + OFF_QL0;
  int tid = threadIdx.x; asm volatile("" : "+v"(tid));
  const int lane = tid & 63, wid = __builtin_amdgcn_readfirstlane(tid >> 6), g = lane >> 4, r16 = lane & 15;
  for (int i = tid; i < 129 * 32; i += 512) {
    const int d = i >> 5, hd = i & 31; int bucket = d;
    if (d >= 16) { bucket = 16 + (d >= 19) + (d >= 21) + (d >= 24) + (d >= 27) + (d >= 31) + (d >= 35) + (d >= 40) + (d >= 46) + (d >= 52) + (d >= 59) + (d >= 67) + (d >= 77) + (d >= 87) + (d >= 99) + (d >= 113); }
    biasd[i] = ((const float*)(p.ws + OFF_SMALL))[SM_RELB + bucket * 32 + hd] * LOG2E;
  }
  LAS unsigned* pcnt = (LAS unsigned*)((LAS unsigned char*)lds + 2 * CBUF + 129 * 32 * 4 + 2048) + (wid >> 1);
  if (tid < 4) ((LAS unsigned*)((LAS unsigned char*)lds + 2 * CBUF + 129 * 32 * 4 + 2048))[tid] = 0u;
  __syncthreads();
  unsigned epoch = 0u;
  const int tok = wid >> 1, hw = wid & 1, head = hw * 16 + r16;
  const float SC = 0.08838834764831845f * LOG2E;
  const int qoff = 16 * (g ^ (r16 >> 3));
  const int q4 = r16 >> 2, pp = r16 & 3;
  const int troff = (4 * g + q4) * CROW + 16 * ((pp >> 1) ^ (g >> 1)) + 8 * (pp & 1);
  const int wrow = 16 * hw + 8 * (lane >> 5), wch = lane & 31;
  for (int round = 0; round * nb < T / 4; ++round) {
    const int item = round * nb + (bid + round * 37) % nb;
    const int tg0 = item * 4, b = tg0 >> 11, t0 = tg0 & 2047, t = t0 + tok, tg = tg0 + tok;
    const int nk = min(t + 1, 256), nkmax = min(t0 + 4, 256), nch = (nkmax + 31) >> 5;
    ((LAS unsigned*)idxs)[tid] = ((const unsigned*)(idxg + (size_t)tg0 * 256))[tid];
    unsigned char* qrow = QL + (size_t)tg * 8192 + head * 256;
    bf16x8 qB[8];
#pragma unroll
    for (int s = 0; s < 8; ++s) { const u32x2 qw = *(const u32x2*)(qrow + 32 * s + 8 * g);
      typedef float f32x2v __attribute__((ext_vector_type(2)));
      const f32x2v a0 = __builtin_amdgcn_cvt_pk_f32_fp8(qw[0], false), a1 = __builtin_amdgcn_cvt_pk_f32_fp8(qw[0], true), a2 = __builtin_amdgcn_cvt_pk_f32_fp8(qw[1], false), a3 = __builtin_amdgcn_cvt_pk_f32_fp8(qw[1], true);
      u32x4 pw; pw[0] = cvt_pk_bf16(a0[0], a0[1]); pw[1] = cvt_pk_bf16(a1[0], a1[1]); pw[2] = cvt_pk_bf16(a2[0], a2[1]); pw[3] = cvt_pk_bf16(a3[0], a3[1]);
      union { u32x4 u; bf16x8 v; } cv; cv.u = pw; qB[s] = cv.v; }
    epoch += 2u; pair_sync(pcnt, epoch, lane);
    u32x4 stg[8];
    const bf16_t* cbase = ckvn + (size_t)b * L * 256 + wch * 8;
#define P4_LOAD(ch) do { const u32x4 kk_ = *(const LAS u32x4*)(idxs + tok * 256 + (ch) * 32 + wrow); \
      _Pragma("unroll") for (int i = 0; i < 8; ++i) { \
      const int key = (int)((kk_[i >> 1] >> (16 * (i & 1))) & 0xffffu); stg[i] = *(const u32x4*)(cbase + (size_t)key * 256); } } while (0)
#define P4_WRITE(bufp) do { _Pragma("unroll") for (int i = 0; i < 8; ++i) \
      *(LAS u32x4*)((bufp) + (wrow + i) * CROW + 16 * (wch ^ (lane >> 5))) = stg[i]; } while (0)
    P4_LOAD(0);
    P4_WRITE(cbuf + tok * CTOK);
    if (nch > 1) P4_LOAD(1);
    float m_run = -1e30f, l_run = 0.f;
    f32x4 o[16];
#pragma unroll
    for (int ct = 0; ct < 16; ++ct) o[ct] = (f32x4){0.f, 0.f, 0.f, 0.f};
    epoch += 2u; pair_sync(pcnt, epoch, lane);
    for (int ch = 0; ch < nch; ++ch) {
      LAS unsigned char* cb = cbuf + (ch & 1) * CBUF + tok * CTOK;
      if (ch + 1 < nch) { P4_WRITE(cbuf + ((ch + 1) & 1) * CBUF + tok * CTOK); if (ch + 2 < nch) P4_LOAD(ch + 2); }
      f32x4 s0 = (f32x4){0.f, 0.f, 0.f, 0.f}, s1 = (f32x4){0.f, 0.f, 0.f, 0.f};
#pragma unroll
      for (int s = 0; s < 8; ++s) {
        const bf16x8 a0 = *(const LAS bf16x8*)(cb + r16 * CROW + s * 64 + qoff);
        const bf16x8 a1 = *(const LAS bf16x8*)(cb + (16 + r16) * CROW + s * 64 + qoff);
        s0 = __builtin_amdgcn_mfma_f32_16x16x32_bf16(a0, qB[s], s0, 0, 0, 0);
        s1 = __builtin_amdgcn_mfma_f32_16x16x32_bf16(a1, qB[s], s1, 0, 0, 0);
      }
      const int slotb = ch * 32 + 4 * g;
      const u32x2 k0 = *(const LAS u32x2*)(idxs + tok * 256 + slotb), k1 = *(const LAS u32x2*)(idxs + tok * 256 + slotb + 16);
      float lg0[4], lg1[4]; float mx = -1e30f;
#pragma unroll
      for (int i = 0; i < 4; ++i) {
        const int key0 = (int)((k0[i >> 1] >> (16 * (i & 1))) & 0xffffu), key1 = (int)((k1[i >> 1] >> (16 * (i & 1))) & 0xffffu);
        const int d0 = min(max(t - key0, 0), 128), d1 = min(max(t - key1, 0), 128);
        lg0[i] = (slotb + i < nk) ? s0[i] * SC + biasd[d0 * 32 + head] : -1e30f;
        lg1[i] = (slotb + 16 + i < nk) ? s1[i] * SC + biasd[d1 * 32 + head] : -1e30f;
        mx = vmax(mx, vmax(lg0[i], lg1[i]));
      }
      mx = pmax32(pmax16(mx));
      float alpha = 1.f;
      if (__ballot(mx > m_run + 8.f) != 0ull) {
        const float m_new = vmax(m_run, mx); alpha = __builtin_amdgcn_exp2f(m_run - m_new); m_run = m_new;
#pragma unroll
        for (int ct = 0; ct < 16; ++ct) o[ct] *= alpha;
      }
      float ps = 0.f; f32x4 p0, p1;
#pragma unroll
      for (int i = 0; i < 4; ++i) { p0[i] = __builtin_amdgcn_exp2f(lg0[i] - m_run); p1[i] = __builtin_amdgcn_exp2f(lg1[i] - m_run); ps += p0[i] + p1[i]; }
      l_run = l_run * alpha + ps;
      const u32x4 pw = pack8(p0, p1);
      bf16x8 pb; { union { u32x4 u; bf16x8 v; } cv; cv.u = pw; pb = cv.v; }
      LAS unsigned char* trb = cb + troff;
#pragma unroll
      for (int ct = 0; ct < 16; ++ct) {
        const s16x4 ta = __builtin_amdgcn_ds_read_tr16_b64_v4i16((LAS s16x4*)(trb + 32 * ct));
        const s16x4 tb = __builtin_amdgcn_ds_read_tr16_b64_v4i16((LAS s16x4*)(trb + 16 * CROW + 32 * ct));
        const bf16x8 a = {ta[0], ta[1], ta[2], ta[3], tb[0], tb[1], tb[2], tb[3]};
        o[ct] = __builtin_amdgcn_mfma_f32_16x16x32_bf16(a, pb, o[ct], 0, 0, 0);
      }
      epoch += 2u; pair_sync(pcnt, epoch, lane);
    }
    const float l = psum32(psum16(l_run));
    const float inv = 16.f / l;
    unsigned char* orow = qrow + 4 * g;
#pragma unroll
    for (int ct = 0; ct < 16; ++ct) {
      unsigned w = __builtin_amdgcn_cvt_pk_fp8_f32(o[ct][0] * inv, o[ct][1] * inv, 0, false); w = __builtin_amdgcn_cvt_pk_fp8_f32(o[ct][2] * inv, o[ct][3] * inv, w, true);
      if (!dry) *(unsigned*)(orow + 16 * ct) = w;
    }
#undef P4_LOAD
#undef P4_WRITE
  }
}

__device__ __forceinline__ void p8_pool(const Params& p, int bid, int nb) {
  const bf16_t* U = (const bf16_t*)(p.ws + OFF_RQ); const bf16_t* Z = (const bf16_t*)(p.ws + OFF_RZ); bf16_t* Y = (bf16_t*)p.out;
  int tid = threadIdx.x; asm volatile("" : "+v"(tid));
  const int n0 = tid * 8, w = 2 << (tid >> 7);
  float bg[8], scl[8];
#pragma unroll
  for (int j = 0; j < 8; ++j) { bg[j] = ((const float*)(p.ws + OFF_SMALL))[SM_BGRP + n0 + j]; scl[j] = ((const float*)(p.ws + OFF_SMALL))[SM_SCALE + n0 + j]; }
  for (int item = bid; item < T / 32; item += nb) {
    const int tg0 = item * 32, t0 = tg0 & 2047;
    const bf16_t* ub = U + (size_t)(tg0 - t0) * 4096 + n0;
    float sum[8];
#pragma unroll
    for (int j = 0; j < 8; ++j) sum[j] = 0.f;
    { u32x4 pv[15];
#pragma unroll
      for (int k = 1; k < 16; ++k) { const int s = t0 - k; pv[k - 1] = (k < w && s >= 0) ? *(const u32x4*)(ub + (size_t)s * 4096) : (u32x4){0u, 0u, 0u, 0u}; }
#pragma unroll
      for (int k = 0; k < 15; ++k)
#pragma unroll
        for (int j = 0; j < 4; ++j) { sum[2 * j] += bflo(pv[k][j]); sum[2 * j + 1] += bfhi(pv[k][j]); } }
    for (int tb = 0; tb < 32; tb += 4) {
      u32x4 cv[4], zv[4], ov[4];
#pragma unroll
      for (int k = 0; k < 4; ++k) {
        const int t = t0 + tb + k;
        cv[k] = *(const u32x4*)(ub + (size_t)t * 4096);
        zv[k] = *(const u32x4*)(Z + (size_t)(tg0 + tb + k) * 4096 + n0);
        ov[k] = (t - w + 1 >= 0) ? *(const u32x4*)(ub + (size_t)(t - w + 1) * 4096) : (u32x4){0u, 0u, 0u, 0u};
      }
#pragma unroll
      for (int k = 0; k < 4; ++k) {
        const int t = t0 + tb + k;
        float cur[8], zf[8], y[8];
#pragma unroll
        for (int j = 0; j < 4; ++j) { cur[2 * j] = bflo(cv[k][j]); cur[2 * j + 1] = bfhi(cv[k][j]); zf[2 * j] = bflo(zv[k][j]); zf[2 * j + 1] = bfhi(zv[k][j]); }
        const float icnt = __builtin_amdgcn_rcpf((float)min(w, t + 1));
#pragma unroll
        for (int j = 0; j < 8; ++j) { sum[j] += cur[j]; y[j] = ((sum[j] * icnt - cur[j]) + bg[j]) * scl[j] * silu_fast(zf[j]); }
        u32x4 o; o[0] = cvt_pk_bf16(y[0], y[1]); o[1] = cvt_pk_bf16(y[2], y[3]); o[2] = cvt_pk_bf16(y[4], y[5]); o[3] = cvt_pk_bf16(y[6], y[7]);
        *(u32x4*)(Y + (size_t)(tg0 + tb + k) * 4096 + n0) = o;
#pragma unroll
        for (int j = 0; j < 4; ++j) { sum[2 * j] -= bflo(ov[k][j]); sum[2 * j + 1] -= bfhi(ov[k][j]); }
        asm volatile("" ::: "memory");
      }
    }
  }
}

__device__ __forceinline__ void p10_final(const Params& p, int bid, int nb) {
  int tid = threadIdx.x; asm volatile("" : "+v"(tid));
  const int lane = tid & 63, wid = tid >> 6;
  const float* ss2 = (const float*)(p.ws + OFF_SS) + 2 * T;
  const bf16_t* h2 = (const bf16_t*)(p.ws + OFF_RQ);
  f32x4 g[8];
#pragma unroll
  for (int j = 0; j < 8; ++j) g[j] = *(const f32x4*)((const float*)(p.ws + OFF_SMALL) + SM_FINAL + (lane + 64 * j) * 4);
  for (int row = bid * 8 + wid; row < T; row += nb * 8) {
    const float r = rsqrtf(ss2[row] * (1.f / 2048.f) + EPS);
    f32x4* ptr = (f32x4*)(p.out + (size_t)row * D);
    u32x2 hv[8];
#pragma unroll
    for (int j = 0; j < 8; ++j) hv[j] = *(const u32x2*)(h2 + (size_t)row * D + (lane + 64 * j) * 4);
#pragma unroll
    for (int j = 0; j < 8; ++j) { const f32x4 v = {bflo(hv[j][0]), bfhi(hv[j][0]), bflo(hv[j][1]), bfhi(hv[j][1])}; ptr[lane + 64 * j] = v * r * g[j]; }
  }
}

__device__ __forceinline__ void grid_bar(unsigned* ctr, unsigned target) {
  __syncthreads();
  if (threadIdx.x == 0) {
    __builtin_amdgcn_fence(__ATOMIC_RELEASE, "agent");
    asm volatile("s_waitcnt vmcnt(0)" ::: "memory");
    __hip_atomic_fetch_add(ctr, 1u, __ATOMIC_RELAXED, __HIP_MEMORY_SCOPE_AGENT);
    while (__hip_atomic_load(ctr, __ATOMIC_RELAXED, __HIP_MEMORY_SCOPE_AGENT) < target) __builtin_amdgcn_s_sleep(2);
    __builtin_amdgcn_fence(__ATOMIC_ACQUIRE, "agent");
    asm volatile("s_waitcnt vmcnt(0)" ::: "memory");
  }
  __syncthreads();
}

__global__ void __launch_bounds__(512, 2) fwd_mega(Params p) {
  extern __shared__ __attribute__((aligned(16))) unsigned char lds[];
  cg::grid_group grid = cg::this_grid();
  const int bid = blockIdx.x, nb = gridDim.x;
  unsigned char* ws = p.ws;
  LAS unsigned char* gl = (LAS unsigned char*)lds;
  float* ss = (float*)(ws + OFF_SS);
  unsigned* bar = (unsigned*)(ws + OFF_BAR);

#define REPS(k)
#define DRY false
  if (bid == 0 && threadIdx.x == 0) __hip_atomic_store(bar, 0u, __ATOMIC_RELAXED, __HIP_MEMORY_SCOPE_AGENT);
  REPS(0) { p0_prep(p, lds, bid, nb); __syncthreads(); }
  grid.sync();

  REPS(1) {
    g8::Sched S; S.init(16, 8, nb, (bid + (nb >> 1)) % nb); S.A0 = (const char*)(ws + OFF_WG); S.sAm = (size_t)256 * 1024 * 2; S.B0 = (const char*)(ws + OFF_WU); S.sBn = (size_t)256 * 1024 * 2; S.sBg = (size_t)2048 * 1024 * 2; S.gshift = 2;
    g8::EpiBf16 E{(bf16_t*)(ws + OFF_WB), nullptr, 1 << 30, LDWB, nullptr};
    g8::gemm_phase(gl, 1024, 1024, 1024, S, E);
  }
  REPS(2) {
    { g8::Sched S; S.init(128, 32, nb, bid); S.A0 = (const char*)(ws + OFF_XQ); S.sAm = (size_t)256 * 2048; S.B0 = (const char*)(ws + OFF_WA); S.sBn = (size_t)256 * 2048;
      g8::EpiProjA E{ss, (bf16_t*)(ws + OFF_RQ), (bf16_t*)(ws + OFF_RZ), (float*)(ws + OFF_CKVR), (bf16_t*)(ws + OFF_QIDX), (bf16_t*)(ws + OFF_KIDX), (float*)(ws + OFF_WIDX), (const float*)(ws + OFF_SMALL) + SM_KIDXN, 0, 1.f / 64.f};
      g8::gemm_phase<g8::EpiProjA, true>(gl, 1024, 1024, 1024, S, E); }
    { g8::Sched S; S.init(128, 6, nb, bid); S.A0 = (const char*)(ws + OFF_QL0); S.sAm = (size_t)256 * 2048 * 2; S.B0 = (const char*)(ws + OFF_WAI); S.sBn = (size_t)256 * 2048 * 2;
      g8::EpiProjA E{ss, (bf16_t*)(ws + OFF_RQ), (bf16_t*)(ws + OFF_RZ), (float*)(ws + OFF_CKVR), (bf16_t*)(ws + OFF_QIDX), (bf16_t*)(ws + OFF_KIDX), (float*)(ws + OFF_WIDX), (const float*)(ws + OFF_SMALL) + SM_KIDXN, 32, 1.f};
      g8::gemm_phase(gl, 2048, 2048, 2048, S, E); }
  }
  grid_bar(bar, (unsigned)(1 * nb));

  REPS(3) { p3_indexer(p, lds, bid, nb, 1, 1); __syncthreads(); }
  REPS(11) { p3_ckvnorm(p, bid, nb); }
  __syncthreads();
  REPS(12) {
    g8::Sched S; S.init(128, 32, nb, bid); S.A0 = (const char*)(ws + OFF_RQ); S.sAm = (size_t)256 * 4096; S.sAn = 256; S.anshift = 1; S.B0 = (const char*)(ws + OFF_WUK); S.sBn = (size_t)256 * 256;
    g8::EpiQlat E{ws + OFF_QL0, 1.f / 16.f};
    g8::gemm_phase<g8::EpiQlat, true, 2>(gl, 128, 2048, 128, S, E);
  }
  grid_bar(bar, (unsigned)(2 * nb));

  REPS(4) { p4_attn(p, lds, bid, nb, DRY); __syncthreads(); }
  grid_bar(bar, (unsigned)(3 * nb));

  REPS(5) {
    g8::Sched S; S.init(128, 16, nb, bid); S.A0 = (const char*)(ws + OFF_QL0); S.sAm = (size_t)256 * 8192; S.sAn = 512; S.B0 = (const char*)(ws + OFF_WUV); S.sBn = (size_t)256 * 512;
    g8::EpiGate E{ws + OFF_RQ, ws + OFF_RZ, 16.f / 256.f};
    g8::gemm_phase<g8::EpiGate, true, 1>(gl, 256, 4096, 256, S, E);
  }
  grid_bar(bar, (unsigned)(4 * nb));

  REPS(6) {
    g8::Sched S; S.init(128, 8, nb, bid); S.A0 = (const char*)(ws + OFF_RQ); S.sAm = (size_t)256 * 4096; S.B0 = (const char*)(ws + OFF_WOUTA); S.sBn = (size_t)256 * 4096;
    g8::EpiRes E{p.x, nullptr, 0, nullptr, (bf16_t*)(ws + OFF_QL0), LDH, ss + T, 1.f / 1024.f};
    g8::gemm_phase<g8::EpiRes, true>(gl, 2048, 2048, 2048, S, E);
  }
  grid_bar(bar, (unsigned)(5 * nb));

  REPS(7) {
    g8::Sched S; S.init(128, 32, nb, bid); S.A0 = (const char*)(ws + OFF_QL0); S.sAm = (size_t)256 * LDH * 2; S.B0 = (const char*)(ws + OFF_WB); S.sBn = (size_t)256 * LDWB * 2;
    g8::EpiBf16 E{(bf16_t*)(ws + OFF_RQ), (bf16_t*)(ws + OFF_RZ), 16, 4096, ss + T};
    g8::gemm_phase(gl, 2048, LDH, LDWB, S, E);
  }
  grid_bar(bar, (unsigned)(6 * nb));

  REPS(8) { p8_pool(p, bid, nb); }
  grid_bar(bar, (unsigned)(7 * nb));

  REPS(9) {
    g8::Sched S; S.init(128, 8, nb, bid); S.A0 = (const char*)p.out; S.sAm = (size_t)256 * 4096 * 2; S.B0 = (const char*)(ws + OFF_WOUTB); S.sBn = (size_t)256 * 4096 * 2;
    g8::EpiRes E{nullptr, (const bf16_t*)(ws + OFF_QL0), LDH, nullptr, (bf16_t*)(ws + OFF_RQ), 2048, ss + 2 * T, 1.f};
    g8::gemm_phase(gl, 4096, 4096, 4096, S, E);
  }
  grid_bar(bar, (unsigned)(8 * nb));

  p10_final(p, bid, nb);
}

extern "C" void kernel_launch(void* const* d_in, const int* in_sizes, int n_in,
                              void* d_out, int out_size, void* d_ws, size_t ws_size,
                              hipStream_t stream) {
  static int grid_blocks = 0;
  if (!grid_blocks) {
    int dev = 0, cus = 0, per_cu = 0;
    (void)hipGetDevice(&dev);
    (void)hipDeviceGetAttribute(&cus, hipDeviceAttributeMultiprocessorCount, dev);
    (void)hipFuncSetAttribute((const void*)fwd_mega, hipFuncAttributeMaxDynamicSharedMemorySize, LDS_BYTES);
    (void)hipOccupancyMaxActiveBlocksPerMultiprocessor(&per_cu, (const void*)fwd_mega, 512, LDS_BYTES);
    if (per_cu < 1) per_cu = 1;
    grid_blocks = cus * per_cu;
    if (ws_size < WS_END) fprintf(stderr, "kernel_launch: workspace too small: %zu < %zu\n", ws_size, (size_t)WS_END);
  }
  Params p{};
  p.x = (const float*)d_in[0]; p.norm_a = (const float*)d_in[1]; p.w_in_a = (const float*)d_in[2]; p.kv_norm = (const float*)d_in[3];
  p.kidx_norm = (const float*)d_in[4]; p.w_uk = (const float*)d_in[5]; p.w_uv = (const float*)d_in[6]; p.w_out_a = (const float*)d_in[7];
  p.norm_b = (const float*)d_in[8]; p.w_in_b = (const float*)d_in[9]; p.w_grp = (const float*)d_in[10]; p.b_grp = (const float*)d_in[11];
  p.scale_b = (const float*)d_in[12]; p.w_out_b = (const float*)d_in[13]; p.rel_bias = (const float*)d_in[14]; p.final_norm = (const float*)d_in[15];
  p.out = (float*)d_out; p.ws = (unsigned char*)d_ws; p.probe = PROBE_PHASE; p.pad = 0;
  void* args[] = {&p};
  hipError_t e = hipLaunchCooperativeKernel((void*)fwd_mega, dim3(grid_blocks), dim3(512), args, LDS_BYTES, stream);
  if (e != hipSuccess) fprintf(stderr, "cooperative launch failed: %s (grid %d)\n", hipGetErrorString(e), grid_blocks);
}
```

```cpp
#include <hip/hip_runtime.h>
#include <hip/hip_cooperative_groups.h>
#include <cstdio>
#include <cstdint>
namespace cg = cooperative_groups;

#define LAS __attribute__((address_space(3)))
typedef unsigned short bf16_t;
typedef short bf16x8 __attribute__((ext_vector_type(8)));
typedef short s16x4 __attribute__((ext_vector_type(4)));
typedef float f32x4 __attribute__((ext_vector_type(4)));
typedef float f32x16 __attribute__((ext_vector_type(16)));
typedef unsigned u32x4 __attribute__((ext_vector_type(4)));
typedef unsigned u32x2 __attribute__((ext_vector_type(2)));

constexpr int T = 32768, L = 2048, D = 2048, DI = 4096;
constexpr float EPS = 1e-6f;
constexpr float LOG2E = 1.4426950408889634f;
constexpr int LDS_BYTES = 156 * 1024;
#ifndef PROBE_PHASE
#define PROBE_PHASE -1
#endif

constexpr size_t OFF_RQ = 0;
constexpr size_t OFF_RZ = 268435456;
constexpr size_t OFF_QL0 = 536870912;
constexpr size_t OFF_XQ = OFF_QL0 + 134217728;
constexpr size_t OFF_WOUTA = 805306368;
constexpr size_t OFF_WB = OFF_WOUTA + 16777216;
constexpr int LDH = 2112, LDWB = 2112;
constexpr size_t OFF_WU = OFF_WB + (size_t)8192 * LDWB * 2;
constexpr size_t OFF_WG = OFF_WU + 16777216;
constexpr size_t OFF_WOUTB = OFF_WG + 8388608;
constexpr size_t OFF_WUK = OFF_WOUTB + 16777216;
constexpr size_t OFF_WUV = OFF_WUK + 2097152;
constexpr size_t OFF_WA = OFF_WUV + 4194304;
constexpr size_t OFF_WAI = OFF_WA + (size_t)8192 * 2048;
constexpr size_t OFF_IDX = OFF_WA;
constexpr size_t OFF_CKVN = OFF_WA + 16777216;
constexpr size_t OFF_CKVR = OFF_WA + 39845888;
constexpr size_t OFF_QIDX = OFF_CKVR + 33554432;
constexpr size_t OFF_KIDX = OFF_QIDX + 67108864;
constexpr size_t OFF_WIDX = OFF_KIDX + 4194304;
constexpr size_t OFF_SS = OFF_WIDX + 2097152;
constexpr size_t OFF_BAR = OFF_SS + 3 * 131072;
constexpr size_t OFF_SMALL = OFF_BAR + 256;
constexpr int SM_KIDXN = 0, SM_KVN = 64, SM_RELB = 320, SM_BGRP = 1344, SM_SCALE = 5440, SM_FINAL = 9536, SM_TOTAL = 11584;
constexpr size_t WS_END = OFF_SMALL + (size_t)SM_TOTAL * 4;

struct Params {
  const float *x, *norm_a, *w_in_a, *kv_norm, *kidx_norm, *w_uk, *w_uv, *w_out_a, *norm_b, *w_in_b, *w_grp, *b_grp, *scale_b, *w_out_b, *rel_bias, *final_norm;
  float* out; unsigned char* ws; int probe; int pad;
};

__device__ __forceinline__ unsigned cvt_pk_bf16(float lo, float hi) { unsigned r; asm("v_cvt_pk_bf16_f32 %0, %1, %2" : "=v"(r) : "v"(lo), "v"(hi)); return r; }
__device__ __forceinline__ float bf2f(unsigned short b) { return __uint_as_float(((unsigned)b) << 16); }
__device__ __forceinline__ float bflo(unsigned w) { return __uint_as_float(w << 16); }
__device__ __forceinline__ float bfhi(unsigned w) { return __uint_as_float(w & 0xffff0000u); }
__device__ __forceinline__ u32x4 pack8(f32x4 a, f32x4 b) { u32x4 w; w[0] = cvt_pk_bf16(a[0], a[1]); w[1] = cvt_pk_bf16(a[2], a[3]); w[2] = cvt_pk_bf16(b[0], b[1]); w[3] = cvt_pk_bf16(b[2], b[3]); return w; }
__device__ __forceinline__ float sx(float v, int mask, int lane) { return __int_as_float(__builtin_amdgcn_ds_bpermute((lane ^ mask) << 2, __float_as_int(v))); }
typedef unsigned u32x2s __attribute__((ext_vector_type(2)));
__device__ __forceinline__ float pmax16(float x) { const u32x2s r = __builtin_amdgcn_permlane16_swap(__float_as_uint(x), __float_as_uint(x), false, false); return __builtin_amdgcn_fmed3f(__uint_as_float(r[0]), __uint_as_float(r[1]), __builtin_inff()); }
__device__ __forceinline__ float pmax32(float x) { const u32x2s r = __builtin_amdgcn_permlane32_swap(__float_as_uint(x), __float_as_uint(x), false, false); return __builtin_amdgcn_fmed3f(__uint_as_float(r[0]), __uint_as_float(r[1]), __builtin_inff()); }
__device__ __forceinline__ float psum16(float x) { const u32x2s r = __builtin_amdgcn_permlane16_swap(__float_as_uint(x), __float_as_uint(x), false, false); return __uint_as_float(r[0]) + __uint_as_float(r[1]); }
__device__ __forceinline__ float psum32(float x) { const u32x2s r = __builtin_amdgcn_permlane32_swap(__float_as_uint(x), __float_as_uint(x), false, false); return __uint_as_float(r[0]) + __uint_as_float(r[1]); }
template <int CTRL> __device__ __forceinline__ float dppf(float x) { return __int_as_float(__builtin_amdgcn_update_dpp(0, __float_as_int(x), CTRL, 0xf, 0xf, false)); }
__device__ __forceinline__ float vmin(float a, float b) { return __builtin_amdgcn_fmed3f(a, b, -__builtin_inff()); }
__device__ __forceinline__ float pmin16(float x) { const u32x2s r = __builtin_amdgcn_permlane16_swap(__float_as_uint(x), __float_as_uint(x), false, false); return vmin(__uint_as_float(r[0]), __uint_as_float(r[1])); }
__device__ __forceinline__ float pmin32(float x) { const u32x2s r = __builtin_amdgcn_permlane32_swap(__float_as_uint(x), __float_as_uint(x), false, false); return vmin(__uint_as_float(r[0]), __uint_as_float(r[1])); }
__device__ __forceinline__ float wave_sum(float s, int) { s += dppf<0x128>(s); s += dppf<0x124>(s); s += dppf<0x122>(s); s += dppf<0x121>(s); return psum32(psum16(s)); }
__device__ __forceinline__ float wave_max(float s) { s = __builtin_amdgcn_fmed3f(s, dppf<0x128>(s), __builtin_inff()); s = __builtin_amdgcn_fmed3f(s, dppf<0x124>(s), __builtin_inff()); s = __builtin_amdgcn_fmed3f(s, dppf<0x122>(s), __builtin_inff()); s = __builtin_amdgcn_fmed3f(s, dppf<0x121>(s), __builtin_inff()); return pmax32(pmax16(s)); }
__device__ __forceinline__ float wave_min(float s) { s = vmin(s, dppf<0x128>(s)); s = vmin(s, dppf<0x124>(s)); s = vmin(s, dppf<0x122>(s)); s = vmin(s, dppf<0x121>(s)); return pmin32(pmin16(s)); }
__device__ __forceinline__ float vmax(float a, float b) { return __builtin_amdgcn_fmed3f(a, b, __builtin_inff()); }
__device__ __forceinline__ float relu_i(float x) { return __int_as_float(max(__float_as_int(x), 0)); }
__device__ __forceinline__ float silu(float z) { return z / (1.f + __expf(-z)); }
__device__ __forceinline__ float silu_fast(float z) { return z * __builtin_amdgcn_rcpf(1.f + __builtin_amdgcn_exp2f(-1.4426950408889634f * z)); }

namespace g8 {
constexpr int BM = 256, BK = 64, HALF = 128, HTB = HALF * BK * 2, STAGE_BYTES = 8 * HTB, NXCD = 8, WGM = 2;
__device__ __forceinline__ int lds_byte(int r, int c) { const int st = (r >> 4) * 2 + (c >> 5), rr = r & 15, cc = c & 31, ob = rr * 64 + cc * 2; return st * 1024 + (ob ^ (((ob >> 9) & 1) << 5)); }
__device__ __forceinline__ void stage_rc(int b, int& R, int& C) { const int st = b / 1024, sb = b % 1024, swz = sb ^ (((sb >> 9) & 1) << 5); R = (st >> 1) * 16 + swz / 64; C = (st & 1) * 32 + (swz % 64) / 2; }
__device__ __forceinline__ int perm32(int rho) { const int n = rho >> 4, i = rho & 15; return 8 * (i >> 2) + 4 * n + (i & 3); }

struct GUnit { const char* A; const char* B; int pm, pn; };

struct Sched {
  int nM, nN, nwg, G, c;
  const char* A0; const char* A1; int pmSplit; size_t sAm, sAn;
  const char* B0; size_t sBn, sBg; int gshift; int anshift;
  __device__ __forceinline__ void init(int nM_, int nN_, int G_, int c_) { nM = nM_; nN = nN_; nwg = nM * nN; G = G_; c = c_; A1 = nullptr; pmSplit = 1 << 30; sAn = 0; sBg = 0; gshift = 0; anshift = 0; }
  __device__ __forceinline__ bool next(int i, GUnit& u) const {
    const int Lx = i * G + c; if (Lx >= nwg) return false;
    int wgid = Lx; { const int q = nwg / NXCD, r = nwg % NXCD, xcd = wgid % NXCD, off = wgid / NXCD; wgid = (xcd < r ? xcd * (q + 1) : r * (q + 1) + (xcd - r) * q) + off; }
    const int nig = WGM * nN, gid = wgid / nig, fm = gid * WGM, gsz = (nM - fm) < WGM ? (nM - fm) : WGM;
    u.pm = fm + ((wgid % nig) % gsz); u.pn = (wgid % nig) / gsz;
    u.A = (u.pm < pmSplit ? A0 + (size_t)u.pm * sAm : A1 + (size_t)(u.pm - pmSplit) * sAm) + (size_t)(u.pn >> anshift) * sAn;
    u.B = B0 + (size_t)u.pn * sBn + (size_t)(u.pm >> gshift) * sBg;
    return true;
  }
};

typedef int v8i __attribute__((ext_vector_type(8)));
__device__ __forceinline__ v8i cat8(bf16x8 a, bf16x8 b) { union { bf16x8 h[2]; v8i v; } u; u.h[0] = a; u.h[1] = b; return u.v; }
template <class Epi, bool FP8 = false, int BD = 0>
__device__ __forceinline__ void gemm_phase(LAS unsigned char* lds, const int K, const int lda, const int ldb, const Sched& S, const Epi& E) {
  int tid = threadIdx.x; asm volatile("" : "+v"(tid));
  const int wid = __builtin_amdgcn_readfirstlane(tid >> 6), lane = tid & 63, wr = wid >> 2, wc = wid & 3, fr = lane & 15, fq = lane >> 4;
  const int nt = K / BK;
  unsigned voffA, voffB;
  { int R, C; stage_rc(tid * 16, R, C); const int Rb = (R & ~31) + perm32(R & 31); voffA = (unsigned)(R * lda + C) * 2u; voffB = (unsigned)(Rb * ldb + C) * 2u; }
  const size_t p2A = (size_t)64 * lda * 2, p2B = (size_t)64 * ldb * 2;
  const size_t kstep = (size_t)(BK * 2);
  const size_t hstepA = (size_t)HALF * lda * 2, hstepB = (size_t)HALF * ldb * 2;
  const unsigned ldsw = (unsigned)wid * 1024u;
  const int aoff = lds_byte(wr * 64 + fr, fq * 8), boff = lds_byte(wc * 32 + fr, fq * 8);
#define G8_SA(b, h) (((b) * 2 + (h)) * HTB)
#define G8_SB(b, h) ((4 + (b) * 2 + (h)) * HTB)
#define G8_STAGE(bufoff, gbase, NM) do { _Pragma("unroll") for (int _i = 0; _i < 2; ++_i) { \
    const char* _b = (const char*)(gbase) + (_i ? p2##NM : (size_t)0); asm volatile("" : "+s"(_b));     \
    __builtin_amdgcn_global_load_lds((const unsigned*)(_b + voff##NM), (LAS unsigned*)(lds + (bufoff) + ldsw + _i * 8192), 16, 0, 0); } } while (0)
#define G8_LDA(dst, b, h) do { _Pragma("unroll") for (int m = 0; m < 4; ++m) { \
    if constexpr (FP8) dst##8[m] = cat8(*(const LAS bf16x8*)(lds + G8_SA(b, h) + aoff + m * 2048), *(const LAS bf16x8*)(lds + G8_SA(b, h) + aoff + m * 2048 + 1024)); \
    else { _Pragma("unroll") for (int k = 0; k < 2; ++k) dst[m][k] = *(const LAS bf16x8*)(lds + G8_SA(b, h) + aoff + m * 2048 + k * 1024); } } } while (0)
#define G8_LDB(dst, b, h) do { _Pragma("unroll") for (int n = 0; n < 2; ++n) { \
    if constexpr (FP8) dst##8[n] = cat8(*(const LAS bf16x8*)(lds + G8_SB(b, h) + boff + n * 2048), *(const LAS bf16x8*)(lds + G8_SB(b, h) + boff + n * 2048 + 1024)); \
    else { _Pragma("unroll") for (int k = 0; k < 2; ++k) dst[n][k] = *(const LAS bf16x8*)(lds + G8_SB(b, h) + boff + n * 2048 + k * 1024); } } } while (0)
#define G8_MMA(ai, bj, At, Bt) do { __builtin_amdgcn_s_setprio(1); _Pragma("unroll") for (int m = 0; m < 4; ++m) _Pragma("unroll") for (int n = 0; n < 2; ++n) { \
    if constexpr (FP8) acc[ai][bj][m][n] = __builtin_amdgcn_mfma_scale_f32_16x16x128_f8f6f4(Bt##8[n], At##8[m], acc[ai][bj][m][n], 0, 0, 0, 0, 0, 0); \
    else { _Pragma("unroll") for (int k = 0; k < 2; ++k) acc[ai][bj][m][n] = __builtin_amdgcn_mfma_f32_16x16x32_bf16(Bt[n][k], At[m][k], acc[ai][bj][m][n], 0, 0, 0); } } \
    __builtin_amdgcn_s_setprio(0); } while (0)
#define G8_WAIT_V(n) asm volatile("s_waitcnt vmcnt(" #n ")" ::: "memory")
#define G8_WAIT_L(n) asm volatile("s_waitcnt lgkmcnt(" #n ")" ::: "memory")
#define G8_BAR __builtin_amdgcn_s_barrier()
#define G8_SCHED __builtin_amdgcn_sched_barrier(0)
  GUnit cur, nxt; int ui = 0;
  if (!S.next(0, cur)) return;
  f32x4 acc[2][2][4][2];
#pragma unroll
  for (int a = 0; a < 2; ++a)
#pragma unroll
    for (int b = 0; b < 2; ++b)
#pragma unroll
      for (int m = 0; m < 4; ++m)
#pragma unroll
        for (int n = 0; n < 2; ++n) acc[a][b][m][n] = (f32x4){0.f, 0.f, 0.f, 0.f};
  bf16x8 At[4][2], B0[2][2], B1[2][2];
  v8i At8[4], B08[2], B18[2];
  const char* cA = cur.A; const char* cB = cur.B;
  G8_STAGE(G8_SB(0, 0), cB, B); G8_STAGE(G8_SB(0, 1), cB + hstepB, B); G8_STAGE(G8_SA(0, 0), cA, A); G8_STAGE(G8_SA(0, 1), cA + hstepA, A);
  if (wr == 1) G8_BAR;
  G8_WAIT_V(2); G8_BAR;
  G8_STAGE(G8_SB(1, 0), cB + kstep, B); G8_STAGE(G8_SA(1, 0), cA + kstep, A); G8_STAGE(G8_SB(1, 1), cB + hstepB + kstep, B);
  G8_WAIT_V(6); G8_BAR;
  for (;;) {
    const bool has_next = S.next(ui + 1, nxt);
    const char* nA = has_next ? nxt.A : cA; const char* nB = has_next ? nxt.B : cB;
    for (int t = 0; t < nt; t += 2) {
      const bool last = (t == nt - 2);
      const char* a1 = cA + (size_t)(t + 1) * kstep + hstepA;
      const char* a2 = last ? nA : cA + (size_t)(t + 2) * kstep; const char* b2 = last ? nB : cB + (size_t)(t + 2) * kstep;
      const char* a3 = a2 + kstep; const char* b3 = b2 + kstep;
      asm volatile("" : "+s"(a1), "+s"(a2), "+s"(b2), "+s"(a3), "+s"(b3));
      G8_LDB(B0, 0, 0); G8_LDB(B1, 0, 1); G8_SCHED; G8_LDA(At, 0, 0); G8_STAGE(G8_SA(1, 1), a1, A);
      const bool d0a = (BD == 0) || (BD == 1 && t < (nt >> 1)) || (BD == 2 && !(cur.pn & 1));
      const bool d1a = (BD == 0) || (BD == 1 && t >= (nt >> 1)) || (BD == 2 && !(cur.pn & 1));
      const bool d0b = (BD == 0) || (BD == 1 && t < (nt >> 1)) || (BD == 2 && (cur.pn & 1));
      const bool d1b = (BD == 0) || (BD == 1 && t >= (nt >> 1)) || (BD == 2 && (cur.pn & 1));
      G8_WAIT_V(8); G8_WAIT_L(0); G8_BAR; if (d0a) G8_MMA(0, 0, At, B0); if (d1a) G8_MMA(0, 1, At, B1); G8_BAR; G8_SCHED;
      G8_LDA(At, 0, 1); G8_STAGE(G8_SB(0, 0), b2, B); G8_STAGE(G8_SB(0, 1), b2 + hstepB, B); G8_STAGE(G8_SA(0, 0), a2, A);
      G8_WAIT_V(8); G8_WAIT_L(0); G8_BAR; if (d0a) G8_MMA(1, 0, At, B0); if (d1a) G8_MMA(1, 1, At, B1); G8_BAR; G8_SCHED;
      G8_LDB(B0, 1, 0); G8_LDB(B1, 1, 1); G8_SCHED; G8_LDA(At, 1, 0); G8_STAGE(G8_SA(0, 1), a2 + hstepA, A);
      G8_WAIT_V(8); G8_WAIT_L(0); G8_BAR; if (d0b) G8_MMA(0, 0, At, B0); if (d1b) G8_MMA(0, 1, At, B1); G8_BAR; G8_SCHED;
      G8_LDA(At, 1, 1); G8_STAGE(G8_SB(1, 0), b3, B); G8_STAGE(G8_SB(1, 1), b3 + hstepB, B); G8_STAGE(G8_SA(1, 0), a3, A);
      G8_WAIT_V(8); G8_WAIT_L(0); G8_BAR; if (d0b) G8_MMA(1, 0, At, B0); if (d1b) G8_MMA(1, 1, At, B1); G8_BAR; G8_SCHED;
    }
    if (wr == 0) G8_BAR;
    {
      int t2 = threadIdx.x; asm volatile("" : "+v"(t2));
      const int w2 = __builtin_amdgcn_readfirstlane(t2 >> 6), l2 = t2 & 63;
      E(acc, cur, w2 >> 2, w2 & 3, l2 & 15, l2 >> 4); }
    if (!has_next) break;
#pragma unroll
    for (int a = 0; a < 2; ++a)
#pragma unroll
      for (int b = 0; b < 2; ++b)
#pragma unroll
        for (int m = 0; m < 4; ++m)
#pragma unroll
          for (int n = 0; n < 2; ++n) acc[a][b][m][n] = (f32x4){0.f, 0.f, 0.f, 0.f};
    cur = nxt; cA = nA; cB = nB; ++ui;
    if (wr == 1) G8_BAR;
  }
  G8_WAIT_V(0);
  G8_BAR;
#undef G8_SA
#undef G8_SB
#undef G8_STAGE
#undef G8_LDA
#undef G8_LDB
#undef G8_MMA
#undef G8_WAIT_V
#undef G8_WAIT_L
#undef G8_BAR
#undef G8_SCHED
}

typedef f32x4 Acc[2][2][4][2];

struct EpiProjA {
  const float* ss0; bf16_t* q; bf16_t* z; float* ckv; bf16_t* qidx; bf16_t* kidx; float* widx; const float* kg; int pnoff; float osc;
  __device__ __forceinline__ void operator()(const Acc& acc, const GUnit& u, int wr, int wc, int fr, int fq) const {
    const int row0 = u.pm * 256 + wr * 64 + fr, pn = u.pn + pnoff;
#pragma unroll
    for (int ai = 0; ai < 2; ++ai)
#pragma unroll
      for (int m = 0; m < 4; ++m) {
        const int row = row0 + ai * 128 + m * 16;
        const float rs = rsqrtf(ss0[row] * (1.f / 2048.f) + EPS) * osc;
        if (pn < 32) {
          unsigned char* base = (unsigned char*)(pn < 16 ? q : z) + (size_t)row * 4096 + (pn & 15) * 256 + wc * 32 + 8 * fq;
#pragma unroll
          for (int bj = 0; bj < 2; ++bj) { const f32x4 a = acc[ai][bj][m][0] * rs, b = acc[ai][bj][m][1] * rs; u32x2 w;
            w[0] = __builtin_amdgcn_cvt_pk_fp8_f32(a[0], a[1], 0, false); w[0] = __builtin_amdgcn_cvt_pk_fp8_f32(a[2], a[3], w[0], true);
            w[1] = __builtin_amdgcn_cvt_pk_fp8_f32(b[0], b[1], 0, false); w[1] = __builtin_amdgcn_cvt_pk_fp8_f32(b[2], b[3], w[1], true);
            *(u32x2*)(base + bj * 128) = w; }
        } else if (pn == 32) {
          float* base = ckv + (size_t)row * 256 + wc * 32 + 8 * fq;
#pragma unroll
          for (int bj = 0; bj < 2; ++bj) { *(f32x4*)(base + bj * 128) = acc[ai][bj][m][0] * rs; *(f32x4*)(base + bj * 128 + 4) = acc[ai][bj][m][1] * rs; }
        } else if (pn < 37) {
          bf16_t* base = qidx + (size_t)row * 1024 + (pn - 33) * 256 + wc * 32 + 8 * fq;
#pragma unroll
          for (int bj = 0; bj < 2; ++bj) *(u32x4*)(base + bj * 128) = pack8(acc[ai][bj][m][0] * rs, acc[ai][bj][m][1] * rs);
        } else {
          if (wc == 0) {
            f32x4 v[2][2]; float s = 0.f;
#pragma unroll
            for (int bj = 0; bj < 2; ++bj)
#pragma unroll
              for (int n = 0; n < 2; ++n) { v[bj][n] = acc[ai][bj][m][n] * rs; s += v[bj][n][0] * v[bj][n][0] + v[bj][n][1] * v[bj][n][1] + v[bj][n][2] * v[bj][n][2] + v[bj][n][3] * v[bj][n][3]; }
            s = psum32(psum16(s));
            const float kr = rsqrtf(s * (1.f / 64.f) + EPS);
#pragma unroll
            for (int bj = 0; bj < 2; ++bj) {
              const f32x4 g0 = *(const f32x4*)(kg + 32 * bj + 8 * fq), g1 = *(const f32x4*)(kg + 32 * bj + 8 * fq + 4);
              *(u32x4*)(kidx + ((size_t)(row >> 5) * 4 + 2 * bj + (fq >> 1)) * 512 + ((fq & 1) * 32 + (row & 31)) * 8) = pack8(v[bj][0] * kr * g0, v[bj][1] * kr * g1);
            }
          } else if (wc == 1 && fq < 2) {
            float* base = widx + (size_t)row * 16 + 8 * fq;
            *(f32x4*)(base) = acc[ai][0][m][0] * (rs * 0.25f); *(f32x4*)(base + 4) = acc[ai][0][m][1] * (rs * 0.25f);
          }
        }
      }
  }
};

struct EpiBf16 {
  bf16_t* O0; bf16_t* O1; int nsplit; int ld; const float* ss;
  __device__ __forceinline__ void operator()(const Acc& acc, const GUnit& u, int wr, int wc, int fr, int fq) const {
    const int row0 = u.pm * 256 + wr * 64 + fr;
    bf16_t* ob = (u.pn < nsplit ? O0 + (size_t)u.pn * 256 : O1 + (size_t)(u.pn - nsplit) * 256) + wc * 32 + 8 * fq;
#pragma unroll
    for (int ai = 0; ai < 2; ++ai)
#pragma unroll
      for (int m = 0; m < 4; ++m) {
        const int row = row0 + ai * 128 + m * 16;
        const float rs = ss ? rsqrtf(ss[row] * (1.f / 2048.f) + EPS) : 1.f;
#pragma unroll
        for (int bj = 0; bj < 2; ++bj) *(u32x4*)(ob + (size_t)row * ld + bj * 128) = pack8(acc[ai][bj][m][0] * rs, acc[ai][bj][m][1] * rs);
      }
  }
};

struct EpiQlat {
  unsigned char* Q0; float osc;
  __device__ __forceinline__ void operator()(const Acc& acc, const GUnit& u, int wr, int wc, int fr, int fq) const {
    const int row0 = u.pm * 256 + wr * 64 + fr;
    unsigned char* ob = Q0 + (size_t)u.pn * 256 + wc * 32 + 8 * fq;
#pragma unroll
    for (int ai = 0; ai < 2; ++ai)
#pragma unroll
      for (int m = 0; m < 4; ++m) {
        const int row = row0 + ai * 128 + m * 16;
#pragma unroll
        for (int bj = 0; bj < 2; ++bj) { const f32x4 a = acc[ai][bj][m][0] * osc, b = acc[ai][bj][m][1] * osc; u32x2 w;
          w[0] = __builtin_amdgcn_cvt_pk_fp8_f32(a[0], a[1], 0, false); w[0] = __builtin_amdgcn_cvt_pk_fp8_f32(a[2], a[3], w[0], true);
          w[1] = __builtin_amdgcn_cvt_pk_fp8_f32(b[0], b[1], 0, false); w[1] = __builtin_amdgcn_cvt_pk_fp8_f32(b[2], b[3], w[1], true);
          *(u32x2*)(ob + (size_t)row * 8192 + bj * 128) = w; }
      }
  }
};

struct EpiGate {
  unsigned char* Y; const unsigned char* Z; float osc;
  __device__ __forceinline__ void operator()(const Acc& acc, const GUnit& u, int wr, int wc, int fr, int fq) const {
    const int row0 = u.pm * 256 + wr * 64 + fr; const int col0 = u.pn * 256 + wc * 32 + 8 * fq;
#pragma unroll
    for (int ai = 0; ai < 2; ++ai)
#pragma unroll
      for (int m = 0; m < 4; ++m) {
        const size_t off = (size_t)(row0 + ai * 128 + m * 16) * 4096 + col0;
#pragma unroll
        for (int bj = 0; bj < 2; ++bj) {
          const u32x2 zw = *(const u32x2*)(Z + off + bj * 128);
          typedef float f32x2v __attribute__((ext_vector_type(2)));
          const f32x2v z0 = __builtin_amdgcn_cvt_pk_f32_fp8(zw[0], false), z1 = __builtin_amdgcn_cvt_pk_f32_fp8(zw[0], true), z2 = __builtin_amdgcn_cvt_pk_f32_fp8(zw[1], false), z3 = __builtin_amdgcn_cvt_pk_f32_fp8(zw[1], true);
          f32x4 a = acc[ai][bj][m][0] * osc, b = acc[ai][bj][m][1] * osc;
          a[0] *= silu_fast(z0[0]); a[1] *= silu_fast(z0[1]); a[2] *= silu_fast(z1[0]); a[3] *= silu_fast(z1[1]);
          b[0] *= silu_fast(z2[0]); b[1] *= silu_fast(z2[1]); b[2] *= silu_fast(z3[0]); b[3] *= silu_fast(z3[1]);
          u32x2 w; w[0] = __builtin_amdgcn_cvt_pk_fp8_f32(a[0], a[1], 0, false); w[0] = __builtin_amdgcn_cvt_pk_fp8_f32(a[2], a[3], w[0], true);
          w[1] = __builtin_amdgcn_cvt_pk_fp8_f32(b[0], b[1], 0, false); w[1] = __builtin_amdgcn_cvt_pk_fp8_f32(b[2], b[3], w[1], true);
          *(u32x2*)(Y + off + bj * 128) = w;
        }
      }
  }
};

struct EpiRes {
  const float* R; const bf16_t* RB; int ldrb; float* H; bf16_t* HB; int ldhb; float* ss; float osc;
  __device__ __forceinline__ void operator()(const Acc& acc, const GUnit& u, int wr, int wc, int fr, int fq) const {
    const int row0 = u.pm * 256 + wr * 64 + fr; const int col0 = u.pn * 256 + wc * 32 + 8 * fq;
#pragma unroll
    for (int ai = 0; ai < 2; ++ai)
#pragma unroll
      for (int m = 0; m < 4; ++m) {
        const int row = row0 + ai * 128 + m * 16; const size_t off = (size_t)row * 2048 + col0; float s = 0.f;
#pragma unroll
        for (int bj = 0; bj < 2; ++bj) {
          f32x4 r0, r1;
          if (R) { r0 = *(const f32x4*)(R + off + bj * 128); r1 = *(const f32x4*)(R + off + bj * 128 + 4); }
          else { const u32x4 rw = *(const u32x4*)(RB + (size_t)row * ldrb + col0 + bj * 128);
            r0 = (f32x4){bflo(rw[0]), bfhi(rw[0]), bflo(rw[1]), bfhi(rw[1])}; r1 = (f32x4){bflo(rw[2]), bfhi(rw[2]), bflo(rw[3]), bfhi(rw[3])}; }
          const f32x4 h0 = r0 + acc[ai][bj][m][0] * osc, h1 = r1 + acc[ai][bj][m][1] * osc;
          if (H) { *(f32x4*)(H + off + bj * 128) = h0; *(f32x4*)(H + off + bj * 128 + 4) = h1; }
          if (HB) *(u32x4*)(HB + (size_t)row * ldhb + col0 + bj * 128) = pack8(h0, h1);
          s += h0[0] * h0[0] + h0[1] * h0[1] + h0[2] * h0[2] + h0[3] * h0[3] + h1[0] * h1[0] + h1[1] * h1[1] + h1[2] * h1[2] + h1[3] * h1[3];
        }
        s = psum32(psum16(s));
        if (fq == 0) atomicAdd(ss + row, s);
      }
  }
};
}

struct CmA { __device__ __forceinline__ int operator()(int n) const {
  if (n < 4096) return n;
  if (n < 8192) return 5456 + (n - 4096);
  if (n < 8448) return 4096 + (n - 8192);
  if (n < 9472) return 4352 + (n - 8448);
  const int c = n - 9472;
  if (c < 32) return 5376 + c;
  if (c < 48) return 5440 + (c - 32);
  if (c >= 128 && c < 160) return 5376 + 32 + (c - 128);
  return -1; } };
struct CmAI { __device__ __forceinline__ int operator()(int n) const { return CmA{}(n + 8192); } };
struct CmOff { int off; __device__ __forceinline__ int operator()(int n) const { return n + off; } };

template <class CM, bool FP8 = false>
__device__ __forceinline__ void tconv_tile(bf16_t* dst, int ldD, const float* src, int ldS, int kt, int np, const float* gk, CM cm, float* tl, int tid, float wsc = 1.f) {
  {
    { const int c = tid & 63, r = tid >> 6; const int sc0 = cm(np * 128 + c), sc1 = cm(np * 128 + 64 + c);
      float v0[8], v1[8];
#pragma unroll
      for (int pass = 0; pass < 8; ++pass) { const int k = kt * 64 + pass * 8 + r; const float g = (gk ? gk[k] : 1.f) * wsc;
        v0[pass] = (sc0 >= 0) ? src[(size_t)k * ldS + sc0] * g : 0.f; v1[pass] = (sc1 >= 0) ? src[(size_t)k * ldS + sc1] * g : 0.f; }
#pragma unroll
      for (int pass = 0; pass < 8; ++pass) { tl[(pass * 8 + r) * 129 + c] = v0[pass]; tl[(pass * 8 + r) * 129 + 64 + c] = v1[pass]; } }
    __syncthreads();
#pragma unroll
    for (int hf = 0; hf < 2; ++hf) { const int nl = hf * 64 + (tid >> 3), kc = tid & 7; float v[8];
#pragma unroll
      for (int j = 0; j < 8; ++j) v[j] = tl[(kc * 8 + j) * 129 + nl];
      if constexpr (FP8) {
        u32x2 w; w[0] = __builtin_amdgcn_cvt_pk_fp8_f32(v[0], v[1], 0, false); w[0] = __builtin_amdgcn_cvt_pk_fp8_f32(v[2], v[3], w[0], true);
        w[1] = __builtin_amdgcn_cvt_pk_fp8_f32(v[4], v[5], 0, false); w[1] = __builtin_amdgcn_cvt_pk_fp8_f32(v[6], v[7], w[1], true);
        *(u32x2*)((unsigned char*)dst + (size_t)(np * 128 + nl) * ldD + kt * 64 + kc * 8) = w;
      } else {
      u32x4 w; w[0] = cvt_pk_bf16(v[0], v[1]); w[1] = cvt_pk_bf16(v[2], v[3]); w[2] = cvt_pk_bf16(v[4], v[5]); w[3] = cvt_pk_bf16(v[6], v[7]);
      *(u32x4*)(dst + (size_t)(np * 128 + nl) * ldD + kt * 64 + kc * 8) = w; } }
    __syncthreads();
  }
}
template <class CM, bool FP8 = false>
__device__ __forceinline__ void tconv(bf16_t* dst, int ldD, const float* src, int ldS, int Ktiles, int Ntiles, const float* gk, CM cm, float* tl, int bid, int nb, float wsc = 1.f) {
  int tid = threadIdx.x; asm volatile("" : "+v"(tid));
  const int Np = Ntiles >> 1;
  for (int tile = bid; tile < Ktiles * Np; tile += nb) tconv_tile<CM, FP8>(dst, ldD, src, ldS, tile / Np, tile % Np, gk, cm, tl, tid, wsc);
}

__device__ __forceinline__ void p0_prep(const Params& p, unsigned char* lds, int bid, int nb) {
  int tid = threadIdx.x; asm volatile("" : "+v"(tid));
  const int lane = tid & 63, wid = tid >> 6;
  float* tl = (float*)lds;
  unsigned char* ws = p.ws;
  { bf16_t* xb = (bf16_t*)(ws + OFF_QL0); unsigned char* xq = ws + OFF_XQ; float* ss0 = (float*)(ws + OFF_SS);
    for (int row = bid * 8 + wid; row < T; row += nb * 8) {
      const f32x4* src = (const f32x4*)(p.x + (size_t)row * D); float s = 0.f;
#pragma unroll
      for (int j = 0; j < 8; ++j) { const f32x4 v = src[lane + 64 * j]; s += v[0] * v[0] + v[1] * v[1] + v[2] * v[2] + v[3] * v[3];
        u32x2 o; o[0] = cvt_pk_bf16(v[0], v[1]); o[1] = cvt_pk_bf16(v[2], v[3]); *(u32x2*)(xb + (size_t)row * D + (lane + 64 * j) * 4) = o;
        unsigned q8 = __builtin_amdgcn_cvt_pk_fp8_f32(v[0], v[1], 0, false); q8 = __builtin_amdgcn_cvt_pk_fp8_f32(v[2], v[3], q8, true); *(unsigned*)(xq + (size_t)row * D + (lane + 64 * j) * 4) = q8; }
      s = wave_sum(s, lane); if (lane == 0) ss0[row] = s;
    }
    for (int i = bid * 512 + tid; i < 2 * T; i += nb * 512) ss0[T + i] = 0.f;
    { float* sm = (float*)(ws + OFF_SMALL);
      for (int i = bid * 512 + tid; i < SM_TOTAL; i += nb * 512) {
        float v;
        if (i < SM_KVN) v = p.kidx_norm[i]; else if (i < SM_RELB) v = p.kv_norm[i - SM_KVN]; else if (i < SM_BGRP) v = p.rel_bias[i - SM_RELB];
        else if (i < SM_SCALE) v = p.b_grp[i - SM_BGRP]; else if (i < SM_FINAL) v = p.scale_b[i - SM_SCALE]; else v = p.final_norm[i - SM_FINAL];
        sm[i] = v; } } }
  tconv<CmA, true>((bf16_t*)(ws + OFF_WA), 2048, p.w_in_a, 9552, 32, 128, p.norm_a, CmA{}, tl, bid, nb, 64.f);
  tconv((bf16_t*)(ws + OFF_WAI), 2048, p.w_in_a, 9552, 32, 24, p.norm_a, CmAI{}, tl, bid, nb);
  tconv<CmOff, true>((bf16_t*)(ws + OFF_WOUTA), 4096, p.w_out_a, 2048, 64, 32, nullptr, CmOff{0}, tl, bid, nb, 64.f);
  tconv((bf16_t*)(ws + OFF_WB) + (size_t)4096 * LDWB, LDWB, p.w_in_b, 8192, 32, 64, p.norm_b, CmOff{4096}, tl, bid, nb);
  for (int it = bid; it < 512; it += nb) { const int g = it >> 7, rem = it & 127;
    tconv_tile((bf16_t*)(ws + OFF_WG) + (size_t)g * 1048576, 1024, p.w_grp + (size_t)g * 1048576, 1024, rem >> 3, rem & 7, nullptr, CmOff{0}, tl, tid); }
  tconv((bf16_t*)(ws + OFF_WOUTB), 4096, p.w_out_b, 2048, 64, 32, nullptr, CmOff{0}, tl, bid, nb);
  for (int it = bid; it < 128; it += nb) {
    const int h = it >> 2, pair = h >> 1, hh = h & 1;
    tconv_tile<CmOff, true>((bf16_t*)(ws + OFF_WUV + (size_t)pair * 131072 + (size_t)hh * 128 * 512 + hh * 256), 512, p.w_uv + h * 128, 4096, it & 3, 0, nullptr, CmOff{0}, tl, tid, 16.f);
  }
  {
    unsigned char* wv = ws + OFF_WUV;
    for (int i = bid * 512 + tid; i < 32 * 128 * 16; i += nb * 512) {
      const int piece = i & 15, r = (i >> 4) & 127, ph = i >> 11; const int pair = ph >> 1, hh = ph & 1;
      *(u32x4*)(wv + (size_t)pair * 131072 + (size_t)(hh * 128 + r) * 512 + (1 - hh) * 256 + piece * 16) = (u32x4){0u, 0u, 0u, 0u};
    } }
  {
    bf16_t* wu = (bf16_t*)(ws + OFF_WU);
    for (int i = bid * 512 + tid; i < 4 * 2048 * 256; i += nb * 512) {
      const int p4 = i & 255, k = (i >> 8) & 2047, g = i >> 19;
      const f32x4 v = *(const f32x4*)(p.w_in_b + (size_t)k * 8192 + g * 1024 + p4 * 4) * p.norm_b[k];
      u32x2 o; o[0] = cvt_pk_bf16(v[0], v[1]); o[1] = cvt_pk_bf16(v[2], v[3]); *(u32x2*)(wu + (size_t)g * 2097152 + (size_t)k * 1024 + p4 * 4) = o;
    } }
  {
    unsigned char* wk = ws + OFF_WUK;
    for (int i = bid * 512 + tid; i < 16 * 512 * 64; i += nb * 512) {
      const int k4 = i & 63, n = (i >> 6) & 511, pr = i >> 15; const int hh = n >> 8, c = n & 255;
      unsigned w = 0u;
      if ((k4 >> 5) == hh) { const f32x4 v = *(const f32x4*)(p.w_uk + (size_t)c * 4096 + (2 * pr + hh) * 128 + (k4 & 31) * 4) * 16.f;
        w = __builtin_amdgcn_cvt_pk_fp8_f32(v[0], v[1], 0, false); w = __builtin_amdgcn_cvt_pk_fp8_f32(v[2], v[3], w, true); }
      *(unsigned*)(wk + (size_t)pr * 131072 + (size_t)n * 256 + k4 * 4) = w;
    } }
}

__device__ __forceinline__ void p3_ckvnorm(const Params& p, int bid, int nb) {
  int tid = threadIdx.x; asm volatile("" : "+v"(tid));
  const int lane = tid & 63, wid = tid >> 6;
  const float* cr = (const float*)(p.ws + OFF_CKVR); bf16_t* cn = (bf16_t*)(p.ws + OFF_CKVN);
  const f32x4 g = *(const f32x4*)((const float*)(p.ws + OFF_SMALL) + SM_KVN + lane * 4);
  for (int row = bid * 8 + wid; row < T; row += nb * 8) {
    const f32x4 v = *(const f32x4*)(cr + (size_t)row * 256 + lane * 4);
    float s = v[0] * v[0] + v[1] * v[1] + v[2] * v[2] + v[3] * v[3]; s = wave_sum(s, lane);
    const float r = rsqrtf(s * (1.f / 256.f) + EPS);
    u32x2 o; o[0] = cvt_pk_bf16(v[0] * r * g[0], v[1] * r * g[1]); o[1] = cvt_pk_bf16(v[2] * r * g[2], v[3] * r * g[3]);
    *(u32x2*)(cn + (size_t)row * 256 + lane * 4) = o;
  }
}

__device__ __forceinline__ void p3_indexer(const Params& p, unsigned char* lds, int bid, int nb, int rep_sc, int rep_sel) {
  float* sc = (float*)lds;
  const bf16_t* qidx = (const bf16_t*)(p.ws + OFF_QIDX); const bf16_t* kidx = (const bf16_t*)(p.ws + OFF_KIDX); const float* widx = (const float*)(p.ws + OFF_WIDX);
  unsigned short* idxo = (unsigned short*)(p.ws + OFF_IDX);
  int tid = threadIdx.x; asm volatile("" : "+v"(tid));
  const int lane = tid & 63, wid = tid >> 6, h = lane >> 5, l31 = lane & 31;
  for (int round = 0; round * nb + bid < T / 16; ++round) {
    const int item = round * nb + bid;
    const int b = item & 15; int tile = item >> 4; { const int r16 = tile >> 4, j = tile & 15; tile = r16 * 16 + ((r16 & 1) ? 15 - j : j); }
    const int t0 = tile * 16;
    if (t0 < 256) {
      const int tok = tid >> 5, j0 = (tid & 31) * 8, t = t0 + tok;
      unsigned short v[8];
#pragma unroll
      for (int j = 0; j < 8; ++j) v[j] = (unsigned short)((j0 + j <= t) ? (j0 + j) : 0);
      u32x4 w; w[0] = v[0] | ((unsigned)v[1] << 16); w[1] = v[2] | ((unsigned)v[3] << 16); w[2] = v[4] | ((unsigned)v[5] << 16); w[3] = v[6] | ((unsigned)v[7] << 16);
      *(u32x4*)(idxo + (size_t)(b * L + t) * 256 + j0) = w;
      continue;
    }
    for (int rsc = 0; rsc < rep_sc; ++rsc) {
      const int tok = l31 >> 4, head = l31 & 15;
      const bf16_t* arow = qidx + (size_t)(b * L + t0 + 2 * wid + tok) * 1024 + head * 64 + 8 * h;
      bf16x8 aq[4];
#pragma unroll
      for (int ks = 0; ks < 4; ++ks) aq[ks] = *(const bf16x8*)(arow + 16 * ks);
      float wv[16];
#pragma unroll
      for (int tk = 0; tk < 2; ++tk) {
        const float* wp = widx + (size_t)(b * L + t0 + 2 * wid + tk) * 16 + 4 * h;
        const f32x4 w0 = *(const f32x4*)(wp), w1 = *(const f32x4*)(wp + 8);
#pragma unroll
        for (int i = 0; i < 4; ++i) { wv[tk * 8 + i] = w0[i] * 0.125f; wv[tk * 8 + 4 + i] = w1[i] * 0.125f; }
      }
      const unsigned char* kb = (const unsigned char*)(kidx + (size_t)b * 64 * 2048) + tid * 16;
      LAS unsigned char* stgb = (LAS unsigned char*)lds + 131072;
      const int nkt = ((t0 + 15) >> 5) + 1, ngr = (nkt + 1) >> 1;
      u32x4 sv = *(const u32x4*)(kb);
      *(LAS u32x4*)(stgb + tid * 16) = sv;
      if (ngr > 1) sv = *(const u32x4*)(kb + 8192);
      __syncthreads();
      for (int gr = 0; gr < ngr; ++gr) {
        if (gr + 1 < ngr) *(LAS u32x4*)(stgb + ((gr + 1) & 1) * 8192 + tid * 16) = sv;
        if (gr + 2 < ngr) sv = *(const u32x4*)(kb + (size_t)(gr + 2) * 8192);
        const LAS unsigned char* bb = stgb + (gr & 1) * 8192 + lane * 16;
#pragma unroll
        for (int q = 0; q < 2; ++q) {
          f32x16 acc;
#pragma unroll
          for (int i = 0; i < 16; ++i) acc[i] = 0.f;
#pragma unroll
          for (int ks = 0; ks < 4; ++ks) { const bf16x8 bfr = *(const LAS bf16x8*)(bb + q * 4096 + ks * 1024); acc = __builtin_amdgcn_mfma_f32_32x32x16_bf16(aq[ks], bfr, acc, 0, 0, 0); }
          float s0 = 0.f, s1 = 0.f;
#pragma unroll
          for (int i = 0; i < 8; ++i) { s0 += wv[i] * relu_i(acc[i]); s1 += wv[8 + i] * relu_i(acc[8 + i]); }
          s0 = psum32(s0); s1 = psum32(s1);
          sc[(2 * wid + h) * 2048 + 32 * (2 * gr + q) + l31] = h ? s1 : s0;
        }
        __syncthreads();
      }
    }
    __syncthreads();
    LAS unsigned* hist = (LAS unsigned*)((LAS unsigned char*)lds + 131072) + wid * 256;
    LAS unsigned* cand = (LAS unsigned*)((LAS unsigned char*)lds + 131072 + 8192) + wid * 128;
    for (int rsel = 0; rsel < rep_sel; ++rsel)
    for (int qq = 0; qq < 2; ++qq) {
      const int qi = 2 * wid + qq, t = t0 + qi;
      float v[32];
#pragma unroll
      for (int j = 0; j < 32; ++j) v[j] = sc[qi * 2048 + lane + 64 * j];
      float mn = 3.0e38f, mx = -3.0e38f;
#pragma unroll
      for (int j = 0; j < 32; ++j) { const bool valid = (lane + 64 * j) <= t; mn = valid ? fminf(mn, v[j]) : mn; mx = valid ? fmaxf(mx, v[j]) : mx; }
      mn = wave_min(mn); mx = wave_max(mx);
      const float scale = (mx > mn) ? 255.f / (mx - mn) : 0.f;
      *(LAS u32x4*)(hist + lane * 4) = (u32x4){0u, 0u, 0u, 0u};
      asm volatile("" ::: "memory");
#pragma unroll
      for (int j = 0; j < 32; ++j) { const bool valid = (lane + 64 * j) <= t; const int bin = min((int)((v[j] - mn) * scale), 255);
        if (valid) __hip_atomic_fetch_add(hist + bin, 1u, __ATOMIC_RELAXED, __HIP_MEMORY_SCOPE_WORKGROUP); }
      asm volatile("s_waitcnt lgkmcnt(0)" ::: "memory");
      const u32x4 h4 = *(const LAS u32x4*)(hist + lane * 4);
      const int tot = (int)(h4[0] + h4[1] + h4[2] + h4[3]);
      int px = tot;
      px += __builtin_amdgcn_update_dpp(0, px, 0x111, 0xf, 0xf, true); px += __builtin_amdgcn_update_dpp(0, px, 0x112, 0xf, 0xf, true);
      px += __builtin_amdgcn_update_dpp(0, px, 0x114, 0xf, 0xf, true); px += __builtin_amdgcn_update_dpp(0, px, 0x118, 0xf, 0xf, true);
      const int rt0 = __builtin_amdgcn_readlane(px, 15), rt1 = __builtin_amdgcn_readlane(px, 31), rt2 = __builtin_amdgcn_readlane(px, 47), rt3 = __builtin_amdgcn_readlane(px, 63);
      const int pre = px + (lane >= 16 ? rt0 : 0) + (lane >= 32 ? rt1 : 0) + (lane >= 48 ? rt2 : 0);
      const int suf = (rt0 + rt1 + rt2 + rt3) - pre + tot;
      const int S3 = suf - tot + (int)h4[3], S2 = S3 + (int)h4[2], S1 = S2 + (int)h4[1], S0 = S1 + (int)h4[0];
      const unsigned long long bm = __ballot(S0 >= 256);
      const int lstar = 63 - __clzll(bm);
      const int myB = S3 >= 256 ? 3 : (S2 >= 256 ? 2 : (S1 >= 256 ? 1 : 0));
      const int mySB = S3 >= 256 ? S3 : (S2 >= 256 ? S2 : (S1 >= 256 ? S1 : S0));
      const int myh = (int)(S3 >= 256 ? h4[3] : (S2 >= 256 ? h4[2] : (S1 >= 256 ? h4[1] : h4[0])));
      const int B = lstar * 4 + __builtin_amdgcn_readlane(myB, lstar);
      const int m = __builtin_amdgcn_readlane(myh, lstar);
      const int c_hi = __builtin_amdgcn_readlane(mySB, lstar) - m, need = 256 - c_hi;
      unsigned short* op = idxo + (size_t)(b * L + t) * 256;
      int base = 0, cbn = 0;
#pragma unroll
      for (int j = 0; j < 32; ++j) {
        const int e = lane + 64 * j; const bool valid = e <= t; const int bin = min((int)((v[j] - mn) * scale), 255);
        const bool hi = valid && bin > B, eq = valid && bin == B;
        const unsigned long long hm = __ballot(hi), em = __ballot(eq);
        const int pos = base + (int)__builtin_amdgcn_mbcnt_hi((unsigned)(hm >> 32), __builtin_amdgcn_mbcnt_lo((unsigned)hm, 0u));
        const int cpos = cbn + (int)__builtin_amdgcn_mbcnt_hi((unsigned)(em >> 32), __builtin_amdgcn_mbcnt_lo((unsigned)em, 0u));
        if (hi && pos < 256) op[pos] = (unsigned short)e;
        if (eq && cpos < 64) { const unsigned bits = __float_as_uint(v[j]); cand[2 * cpos] = bits ^ ((bits >> 31) ? 0xFFFFFFFFu : 0x80000000u); cand[2 * cpos + 1] = (unsigned)e; }
        base += __popcll(hm); cbn += __popcll(em);
      }
      if (m <= 64) {
        asm volatile("s_waitcnt lgkmcnt(0)" ::: "memory");
        const unsigned ck = (lane < m) ? cand[2 * lane] : 0u, ce = (lane < m) ? cand[2 * lane + 1] : 0xffffu;
        int rank = 0;
        for (int jj = 0; jj < m; ++jj) { const unsigned kj = __builtin_amdgcn_readlane(ck, jj), ej = __builtin_amdgcn_readlane(ce, jj); rank += (kj > ck || (kj == ck && ej < ce)) ? 1 : 0; }
        const bool selc = (lane < m) && (rank < need);
        const unsigned long long sm = __ballot(selc);
        const int pos = c_hi + (int)__builtin_amdgcn_mbcnt_hi((unsigned)(sm >> 32), __builtin_amdgcn_mbcnt_lo((unsigned)sm, 0u));
        if (selc && pos < 256) op[pos] = (unsigned short)ce;
      } else {
#define KEYOF(j) (((lane + 64 * (j)) <= t) ? (__float_as_uint(v[j]) ^ ((__float_as_uint(v[j]) >> 31) ? 0xFFFFFFFFu : 0x80000000u)) : 0u)
        unsigned prefix = 0u;
        for (int bit = 31; bit >= 0; --bit) {
          const unsigned cnd = prefix | (1u << bit); int cnt = 0;
#pragma unroll
          for (int j = 0; j < 32; ++j) cnt += __popcll(__ballot(KEYOF(j) >= cnd));
          if (cnt >= 256) prefix = cnd;
        }
        int cgt = 0;
#pragma unroll
        for (int j = 0; j < 32; ++j) cgt += __popcll(__ballot(KEYOF(j) > prefix));
        const int need2 = 256 - cgt; int base2 = 0, tb = 0;
#pragma unroll
        for (int j = 0; j < 32; ++j) {
          const unsigned uj = KEYOF(j); const bool gt = uj > prefix, eq = (uj == prefix);
          const unsigned long long eqm = __ballot(eq);
          const int trank = tb + (int)__builtin_amdgcn_mbcnt_hi((unsigned)(eqm >> 32), __builtin_amdgcn_mbcnt_lo((unsigned)eqm, 0u));
          const bool sel = gt || (eq && trank < need2);
          const unsigned long long sm = __ballot(sel);
          const int pos = base2 + (int)__builtin_amdgcn_mbcnt_hi((unsigned)(sm >> 32), __builtin_amdgcn_mbcnt_lo((unsigned)sm, 0u));
          if (sel && pos < 256) op[pos] = (unsigned short)(lane + 64 * j);
          base2 += __popcll(sm); tb += __popcll(eqm);
        }
#undef KEYOF
      }
    }
    __syncthreads();
  }
}

__device__ __forceinline__ void pair_sync(LAS unsigned* cnt, unsigned target, int lane) {
  asm volatile("" ::: "memory");
  if (lane == 0) __hip_atomic_fetch_add(cnt, 1u, __ATOMIC_RELAXED, __HIP_MEMORY_SCOPE_WORKGROUP);
  while (__hip_atomic_load(cnt, __ATOMIC_RELAXED, __HIP_MEMORY_SCOPE_WORKGROUP) < target) __builtin_amdgcn_s_sleep(1);
  asm volatile("" ::: "memory");
}
constexpr int CROW = 544;
constexpr int CTOK = 32 * CROW;
constexpr int CBUF = 4 * CTOK;
__device__ __forceinline__ void p4_attn(const Params& p, unsigned char* lds, int bid, int nb, bool dry) {
  LAS unsigned char* cbuf = (LAS unsigned char*)lds;
  LAS float* biasd = (LAS float*)((LAS unsigned char*)lds + 2 * CBUF);
  LAS unsigned short* idxs = (LAS unsigned short*)((LAS unsigned char*)lds + 2 * CBUF + 129 * 32 * 4);
  const bf16_t* ckvn = (const bf16_t*)(p.ws + OFF_CKVN); const unsigned short* idxg = (const unsigned short*)(p.ws + OFF_IDX);
  unsigned char* QL = p.ws + OFF_QL0;
  int tid = threadIdx.x; asm volatile("" : "+v"(tid));
  const int lane = tid & 63, wid = __builtin_amdgcn_readfirstlane(tid >> 6), g = lane >> 4, r16 = lane & 15;
  for (int i = tid; i < 129 * 32; i += 512) {
    const int d = i >> 5, hd = i & 31; int bucket = d;
    if (d >= 16) { bucket = 16 + (d >= 19) + (d >= 21) + (d >= 24) + (d >= 27) + (d >= 31) + (d >= 35) + (d >= 40) + (d >= 46) + (d >= 52) + (d >= 59) + (d >= 67) + (d >= 77) + (d >= 87) + (d >= 99) + (d >= 113); }
    biasd[i] = ((const float*)(p.ws + OFF_SMALL))[SM_RELB + bucket * 32 + hd] * LOG2E;
  }
  LAS unsigned* pcnt = (LAS unsigned*)((LAS unsigned char*)lds + 2 * CBUF + 129 * 32 * 4 + 2048) + (wid >> 1);
  if (tid < 4) ((LAS unsigned*)((LAS unsigned char*)lds + 2 * CBUF + 129 * 32 * 4 + 2048))[tid] = 0u;
  __syncthreads();
  unsigned epoch = 0u;
  const int tok = wid >> 1, hw = wid & 1, head = hw * 16 + r16;
  const float SC = 0.08838834764831845f * LOG2E;
  const int qoff = 16 * (g ^ (r16 >> 3));
  const int q4 = r16 >> 2, pp = r16 & 3;
  const int troff = (4 * g + q4) * CROW + 16 * ((pp >> 1) ^ (g >> 1)) + 8 * (pp & 1);
  const int wrow = 16 * hw + 8 * (lane >> 5), wch = lane & 31;
  for (int round = 0; round * nb < T / 4; ++round) {
    const int item = round * nb + (bid + round * 37) % nb;
    const int tg0 = item * 4, b = tg0 >> 11, t0 = tg0 & 2047, t = t0 + tok, tg = tg0 + tok;
    const int nk = min(t + 1, 256), nkmax = min(t0 + 4, 256), nch = (nkmax + 31) >> 5;
    ((LAS unsigned*)idxs)[tid] = ((const unsigned*)(idxg + (size_t)tg0 * 256))[tid];
    unsigned char* qrow = QL + (size_t)tg * 8192 + head * 256;
    bf16x8 qB[8];
#pragma unroll
    for (int s = 0; s < 8; ++s) { const u32x2 qw = *(const u32x2*)(qrow + 32 * s + 8 * g);
      typedef float f32x2v __attribute__((ext_vector_type(2)));
      const f32x2v a0 = __builtin_amdgcn_cvt_pk_f32_fp8(qw[0], false), a1 = __builtin_amdgcn_cvt_pk_f32_fp8(qw[0], true), a2 = __builtin_amdgcn_cvt_pk_f32_fp8(qw[1], false), a3 = __builtin_amdgcn_cvt_pk_f32_fp8(qw[1], true);
      u32x4 pw; pw[0] = cvt_pk_bf16(a0[0], a0[1]); pw[1] = cvt_pk_bf16(a1[0], a1[1]); pw[2] = cvt_pk_bf16(a2[0], a2[1]); pw[3] = cvt_pk_bf16(a3[0], a3[1]);
      union { u32x4 u; bf16x8 v; } cv; cv.u = pw; qB[s] = cv.v; }
    epoch += 2u; pair_sync(pcnt, epoch, lane);
    u32x4 stg[8];
    const bf16_t* cbase = ckvn + (size_t)b * L * 256 + wch * 8;
#define P4_LOAD(ch) do { const u32x4 kk_ = *(const LAS u32x4*)(idxs + tok * 256 + (ch) * 32 + wrow); \
      _Pragma("unroll") for (int i = 0; i < 8; ++i) { \
      const int key = (int)((kk_[i >> 1] >> (16 * (i & 1))) & 0xffffu); stg[i] = *(const u32x4*)(cbase + (size_t)key * 256); } } while (0)
#define P4_WRITE(bufp) do { _Pragma("unroll") for (int i = 0; i < 8; ++i) \
      *(LAS u32x4*)((bufp) + (wrow + i) * CROW + 16 * (wch ^ (lane >> 5))) = stg[i]; } while (0)
    P4_LOAD(0);
    P4_WRITE(cbuf + tok * CTOK);
    if (nch > 1) P4_LOAD(1);
    float m_run = -1e30f, l_run = 0.f;
    f32x4 o[16];
#pragma unroll
    for (int ct = 0; ct < 16; ++ct) o[ct] = (f32x4){0.f, 0.f, 0.f, 0.f};
    epoch += 2u; pair_sync(pcnt, epoch, lane);
    for (int ch = 0; ch < nch; ++ch) {
      LAS unsigned char* cb = cbuf + (ch & 1) * CBUF + tok * CTOK;
      if (ch + 1 < nch) { P4_WRITE(cbuf + ((ch + 1) & 1) * CBUF + tok * CTOK); if (ch + 2 < nch) P4_LOAD(ch + 2); }
      f32x4 s0 = (f32x4){0.f, 0.f, 0.f, 0.f}, s1 = (f32x4){0.f, 0.f, 0.f, 0.f};
#pragma unroll
      for (int s = 0; s < 8; ++s) {
        const bf16x8 a0 = *(const LAS bf16x8*)(cb + r16 * CROW + s * 64 + qoff);
        const bf16x8 a1 = *(const LAS bf16x8*)(cb + (16 + r16) * CROW + s * 64 + qoff);
        s0 = __builtin_amdgcn_mfma_f32_16x16x32_bf16(a0, qB[s], s0, 0, 0, 0);
        s1 = __builtin_amdgcn_mfma_f32_16x16x32_bf16(a1, qB[s], s1, 0, 0, 0);
      }
      const int slotb = ch * 32 + 4 * g;
      const u32x2 k0 = *(const LAS u32x2*)(idxs + tok * 256 + slotb), k1 = *(const LAS u32x2*)(idxs + tok * 256 + slotb + 16);
      float lg0[4], lg1[4]; float mx = -1e30f;
      const bool full = (ch * 32 + 32 <= nk);
#pragma unroll
      for (int i = 0; i < 4; ++i) {
        const int key0 = (int)((k0[i >> 1] >> (16 * (i & 1))) & 0xffffu), key1 = (int)((k1[i >> 1] >> (16 * (i & 1))) & 0xffffu);
        const int d0 = min(max(t - key0, 0), 128), d1 = min(max(t - key1, 0), 128);
        lg0[i] = s0[i] * SC + biasd[d0 * 32 + head];
        lg1[i] = s1[i] * SC + biasd[d1 * 32 + head];
        if (!full) {
          lg0[i] = (slotb + i < nk) ? lg0[i] : -1e30f;
          lg1[i] = (slotb + 16 + i < nk) ? lg1[i] : -1e30f;
        }
        mx = vmax(mx, vmax(lg0[i], lg1[i]));
      }
      mx = pmax32(pmax16(mx));
      float alpha = 1.f;
      if (__ballot(mx > m_run + 8.f) != 0ull) {
        const float m_new = vmax(m_run, mx); alpha = __builtin_amdgcn_exp2f(m_run - m_new); m_run = m_new;
#pragma unroll
        for (int ct = 0; ct < 16; ++ct) o[ct] *= alpha;
      }
      float ps = 0.f; f32x4 p0, p1;
#pragma unroll
      for (int i = 0; i < 4; ++i) { p0[i] = __builtin_amdgcn_exp2f(lg0[i] - m_run); p1[i] = __builtin_amdgcn_exp2f(lg1[i] - m_run); ps += p0[i] + p1[i]; }
      l_run = l_run * alpha + ps;
      const u32x4 pw = pack8(p0, p1);
      bf16x8 pb; { union { u32x4 u; bf16x8 v; } cv; cv.u = pw; pb = cv.v; }
      LAS unsigned char* trb = cb + troff;
#pragma unroll
      for (int ct = 0; ct < 16; ++ct) {
        const s16x4 ta = __builtin_amdgcn_ds_read_tr16_b64_v4i16((LAS s16x4*)(trb + 32 * ct));
        const s16x4 tb = __builtin_amdgcn_ds_read_tr16_b64_v4i16((LAS s16x4*)(trb + 16 * CROW + 32 * ct));
        const bf16x8 a = {ta[0], ta[1], ta[2], ta[3], tb[0], tb[1], tb[2], tb[3]};
        o[ct] = __builtin_amdgcn_mfma_f32_16x16x32_bf16(a, pb, o[ct], 0, 0, 0);
      }
      epoch += 2u; pair_sync(pcnt, epoch, lane);
    }
    const float l = psum32(psum16(l_run));
    const float inv = 16.f / l;
    unsigned char* orow = qrow + 4 * g;
#pragma unroll
    for (int ct = 0; ct < 16; ++ct) {
      unsigned w = __builtin_amdgcn_cvt_pk_fp8_f32(o[ct][0] * inv, o[ct][1] * inv, 0, false); w = __builtin_amdgcn_cvt_pk_fp8_f32(o[ct][2] * inv, o[ct][3] * inv, w, true);
      if (!dry) *(unsigned*)(orow + 16 * ct) = w;
    }
#undef P4_LOAD
#undef P4_WRITE
  }
}

__device__ __forceinline__ void p8_pool(const Params& p, int bid, int nb) {
  const bf16_t* U = (const bf16_t*)(p.ws + OFF_RQ); const bf16_t* Z = (const bf16_t*)(p.ws + OFF_RZ); bf16_t* Y = (bf16_t*)p.out;
  int tid = threadIdx.x; asm volatile("" : "+v"(tid));
  const int n0 = tid * 8, w = 2 << (tid >> 7);
  float bg[8], scl[8];
#pragma unroll
  for (int j = 0; j < 8; ++j) { bg[j] = ((const float*)(p.ws + OFF_SMALL))[SM_BGRP + n0 + j]; scl[j] = ((const float*)(p.ws + OFF_SMALL))[SM_SCALE + n0 + j]; }
  for (int item = bid; item < T / 32; item += nb) {
    const int tg0 = item * 32, t0 = tg0 & 2047;
    const bf16_t* ub = U + (size_t)(tg0 - t0) * 4096 + n0;
    float sum[8];
#pragma unroll
    for (int j = 0; j < 8; ++j) sum[j] = 0.f;
    { u32x4 pv[15];
#pragma unroll
      for (int k = 1; k < 16; ++k) { const int s = t0 - k; pv[k - 1] = (k < w && s >= 0) ? *(const u32x4*)(ub + (size_t)s * 4096) : (u32x4){0u, 0u, 0u, 0u}; }
#pragma unroll
      for (int k = 0; k < 15; ++k)
#pragma unroll
        for (int j = 0; j < 4; ++j) { sum[2 * j] += bflo(pv[k][j]); sum[2 * j + 1] += bfhi(pv[k][j]); } }
    for (int tb = 0; tb < 32; tb += 4) {
      u32x4 cv[4], zv[4], ov[4];
#pragma unroll
      for (int k = 0; k < 4; ++k) {
        const int t = t0 + tb + k;
        cv[k] = *(const u32x4*)(ub + (size_t)t * 4096);
        zv[k] = *(const u32x4*)(Z + (size_t)(tg0 + tb + k) * 4096 + n0);
        ov[k] = (t - w + 1 >= 0) ? *(const u32x4*)(ub + (size_t)(t - w + 1) * 4096) : (u32x4){0u, 0u, 0u, 0u};
      }
#pragma unroll
      for (int k = 0; k < 4; ++k) {
        const int t = t0 + tb + k;
        float cur[8], zf[8], y[8];
#pragma unroll
        for (int j = 0; j < 4; ++j) { cur[2 * j] = bflo(cv[k][j]); cur[2 * j + 1] = bfhi(cv[k][j]); zf[2 * j] = bflo(zv[k][j]); zf[2 * j + 1] = bfhi(zv[k][j]); }
        const float icnt = __builtin_amdgcn_rcpf((float)min(w, t + 1));
#pragma unroll
        for (int j = 0; j < 8; ++j) { sum[j] += cur[j]; y[j] = ((sum[j] * icnt - cur[j]) + bg[j]) * scl[j] * silu_fast(zf[j]); }
        u32x4 o; o[0] = cvt_pk_bf16(y[0], y[1]); o[1] = cvt_pk_bf16(y[2], y[3]); o[2] = cvt_pk_bf16(y[4], y[5]); o[3] = cvt_pk_bf16(y[6], y[7]);
        *(u32x4*)(Y + (size_t)(tg0 + tb + k) * 4096 + n0) = o;
#pragma unroll
        for (int j = 0; j < 4; ++j) { sum[2 * j] -= bflo(ov[k][j]); sum[2 * j + 1] -= bfhi(ov[k][j]); }
        asm volatile("" ::: "memory");
      }
    }
  }
}

__device__ __forceinline__ void p10_final(const Params& p, int bid, int nb) {
  int tid = threadIdx.x; asm volatile("" : "+v"(tid));
  const int lane = tid & 63, wid = tid >> 6;
  const float* ss2 = (const float*)(p.ws + OFF_SS) + 2 * T;
  const bf16_t* h2 = (const bf16_t*)(p.ws + OFF_RQ);
  f32x4 g[8];
#pragma unroll
  for (int j = 0; j < 8; ++j) g[j] = *(const f32x4*)((const float*)(p.ws + OFF_SMALL) + SM_FINAL + (lane + 64 * j) * 4);
  for (int row = bid * 8 + wid; row < T; row += nb * 8) {
    const float r = rsqrtf(ss2[row] * (1.f / 2048.f) + EPS);
    f32x4* ptr = (f32x4*)(p.out + (size_t)row * D);
    u32x2 hv[8];
#pragma unroll
    for (int j = 0; j < 8; ++j) hv[j] = *(const u32x2*)(h2 + (size_t)row * D + (lane + 64 * j) * 4);
#pragma unroll
    for (int j = 0; j < 8; ++j) { const f32x4 v = {bflo(hv[j][0]), bfhi(hv[j][0]), bflo(hv[j][1]), bfhi(hv[j][1])}; ptr[lane + 64 * j] = v * r * g[j]; }
  }
}

__device__ __forceinline__ void grid_bar(unsigned* ctr, unsigned target) {
  __syncthreads();
  if (threadIdx.x == 0) {
    __builtin_amdgcn_fence(__ATOMIC_RELEASE, "agent");
    asm volatile("s_waitcnt vmcnt(0)" ::: "memory");
    __hip_atomic_fetch_add(ctr, 1u, __ATOMIC_RELAXED, __HIP_MEMORY_SCOPE_AGENT);
    while (__hip_atomic_load(ctr, __ATOMIC_RELAXED, __HIP_MEMORY_SCOPE_AGENT) < target) __builtin_amdgcn_s_sleep(2);
    __builtin_amdgcn_fence(__ATOMIC_ACQUIRE, "agent");
    asm volatile("s_waitcnt vmcnt(0)" ::: "memory");
  }
  __syncthreads();
}

__global__ void __launch_bounds__(512, 2) fwd_mega(Params p) {
  extern __shared__ __attribute__((aligned(16))) unsigned char lds[];
  cg::grid_group grid = cg::this_grid();
  const int bid = blockIdx.x, nb = gridDim.x;
  unsigned char* ws = p.ws;
  LAS unsigned char* gl = (LAS unsigned char*)lds;
  float* ss = (float*)(ws + OFF_SS);
  unsigned* bar = (unsigned*)(ws + OFF_BAR);

#define REPS(k)
#define DRY false
  if (bid == 0 && threadIdx.x == 0) __hip_atomic_store(bar, 0u, __ATOMIC_RELAXED, __HIP_MEMORY_SCOPE_AGENT);
  REPS(0) { p0_prep(p, lds, bid, nb); __syncthreads(); }
  grid.sync();

  REPS(1) {
    g8::Sched S; S.init(16, 8, nb, (bid + (nb >> 1)) % nb); S.A0 = (const char*)(ws + OFF_WG); S.sAm = (size_t)256 * 1024 * 2; S.B0 = (const char*)(ws + OFF_WU); S.sBn = (size_t)256 * 1024 * 2; S.sBg = (size_t)2048 * 1024 * 2; S.gshift = 2;
    g8::EpiBf16 E{(bf16_t*)(ws + OFF_WB), nullptr, 1 << 30, LDWB, nullptr};
    g8::gemm_phase(gl, 1024, 1024, 1024, S, E);
  }
  REPS(2) {
    { g8::Sched S; S.init(128, 32, nb, bid); S.A0 = (const char*)(ws + OFF_XQ); S.sAm = (size_t)256 * 2048; S.B0 = (const char*)(ws + OFF_WA); S.sBn = (size_t)256 * 2048;
      g8::EpiProjA E{ss, (bf16_t*)(ws + OFF_RQ), (bf16_t*)(ws + OFF_RZ), (float*)(ws + OFF_CKVR), (bf16_t*)(ws + OFF_QIDX), (bf16_t*)(ws + OFF_KIDX), (float*)(ws + OFF_WIDX), (const float*)(ws + OFF_SMALL) + SM_KIDXN, 0, 1.f / 64.f};
      g8::gemm_phase<g8::EpiProjA, true>(gl, 1024, 1024, 1024, S, E); }
    { g8::Sched S; S.init(128, 6, nb, bid); S.A0 = (const char*)(ws + OFF_QL0); S.sAm = (size_t)256 * 2048 * 2; S.B0 = (const char*)(ws + OFF_WAI); S.sBn = (size_t)256 * 2048 * 2;
      g8::EpiProjA E{ss, (bf16_t*)(ws + OFF_RQ), (bf16_t*)(ws + OFF_RZ), (float*)(ws + OFF_CKVR), (bf16_t*)(ws + OFF_QIDX), (bf16_t*)(ws + OFF_KIDX), (float*)(ws + OFF_WIDX), (const float*)(ws + OFF_SMALL) + SM_KIDXN, 32, 1.f};
      g8::gemm_phase(gl, 2048, 2048, 2048, S, E); }
  }
  grid_bar(bar, (unsigned)(1 * nb));

  REPS(3) { p3_indexer(p, lds, bid, nb, 1, 1); __syncthreads(); }
  REPS(11) { p3_ckvnorm(p, bid, nb); }
  __syncthreads();
  REPS(12) {
    g8::Sched S; S.init(128, 32, nb, bid); S.A0 = (const char*)(ws + OFF_RQ); S.sAm = (size_t)256 * 4096; S.sAn = 256; S.anshift = 1; S.B0 = (const char*)(ws + OFF_WUK); S.sBn = (size_t)256 * 256;
    g8::EpiQlat E{ws + OFF_QL0, 1.f / 16.f};
    g8::gemm_phase<g8::EpiQlat, true, 2>(gl, 128, 2048, 128, S, E);
  }
  grid_bar(bar, (unsigned)(2 * nb));

  REPS(4) { p4_attn(p, lds, bid, nb, DRY); __syncthreads(); }
  grid_bar(bar, (unsigned)(3 * nb));

  REPS(5) {
    g8::Sched S; S.init(128, 16, nb, bid); S.A0 = (const char*)(ws + OFF_QL0); S.sAm = (size_t)256 * 8192; S.sAn = 512; S.B0 = (const char*)(ws + OFF_WUV); S.sBn = (size_t)256 * 512;
    g8::EpiGate E{ws + OFF_RQ, ws + OFF_RZ, 16.f / 256.f};
    g8::gemm_phase<g8::EpiGate, true, 1>(gl, 256, 4096, 256, S, E);
  }
  grid_bar(bar, (unsigned)(4 * nb));

  REPS(6) {
    g8::Sched S; S.init(128, 8, nb, bid); S.A0 = (const char*)(ws + OFF_RQ); S.sAm = (size_t)256 * 4096; S.B0 = (const char*)(ws + OFF_WOUTA); S.sBn = (size_t)256 * 4096;
    g8::EpiRes E{p.x, nullptr, 0, nullptr, (bf16_t*)(ws + OFF_QL0), LDH, ss + T, 1.f / 1024.f};
    g8::gemm_phase<g8::EpiRes, true>(gl, 2048, 2048, 2048, S, E);
  }
  grid_bar(bar, (unsigned)(5 * nb));

  REPS(7) {
    g8::Sched S; S.init(128, 32, nb, bid); S.A0 = (const char*)(ws + OFF_QL0); S.sAm = (size_t)256 * LDH * 2; S.B0 = (const char*)(ws + OFF_WB); S.sBn = (size_t)256 * LDWB * 2;
    g8::EpiBf16 E{(bf16_t*)(ws + OFF_RQ), (bf16_t*)(ws + OFF_RZ), 16, 4096, ss + T};
    g8::gemm_phase(gl, 2048, LDH, LDWB, S, E);
  }
  grid_bar(bar, (unsigned)(6 * nb));

  REPS(8) { p8_pool(p, bid, nb); }
  grid_bar(bar, (unsigned)(7 * nb));

  REPS(9) {
    g8::Sched S; S.init(128, 8, nb, bid); S.A0 = (const char*)p.out; S.sAm = (size_t)256 * 4096 * 2; S.B0 = (const char*)(ws + OFF_WOUTB); S.sBn = (size_t)256 * 4096 * 2;
    g8::EpiRes E{nullptr, (const bf16_t*)(ws + OFF_QL0), LDH, nullptr, (bf16_t*)(ws + OFF_RQ), 2048, ss + 2 * T, 1.f};
    g8::gemm_phase(gl, 4096, 4096, 4096, S, E);
  }
  grid_bar(bar, (unsigned)(8 * nb));

  p10_final(p, bid, nb);
}

extern "C" void kernel_launch(void* const* d_in, const int* in_sizes, int n_in,
                              void* d_out, int out_size, void* d_ws, size_t ws_size,
                              hipStream_t stream) {
  static int grid_blocks = 0;
  if (!grid_blocks) {
    int dev = 0, cus = 0, per_cu = 0;
    (void)hipGetDevice(&dev);
    (void)hipDeviceGetAttribute(&cus, hipDeviceAttributeMultiprocessorCount, dev);
    (void)hipFuncSetAttribute((const void*)fwd_mega, hipFuncAttributeMaxDynamicSharedMemorySize, LDS_BYTES);
    (void)hipOccupancyMaxActiveBlocksPerMultiprocessor(&per_cu, (const void*)fwd_mega, 512, LDS_BYTES);
    if (per_cu < 1) per_cu = 1;
    grid_blocks = cus * per_cu;
    if (ws_size < WS_END) fprintf(stderr, "kernel_launch: workspace too small: %zu < %zu\n", ws_size, (size_t)WS_END);
  }
  Params p{};
  p.x = (const float*)d_in[0]; p.norm_a = (const float*)d_in[1]; p.w_in_a = (const float*)d_in[2]; p.kv_norm = (const float*)d_in[3];
  p.kidx_norm = (const float*)d_in[4]; p.w_uk = (const float*)d_in[5]; p.w_uv = (const float*)d_in[6]; p.w_out_a = (const float*)d_in[7];
  p.norm_b = (const float*)d_in[8]; p.w_in_b = (const float*)d_in[9]; p.w_grp = (const float*)d_in[10]; p.b_grp = (const float*)d_in[11];
  p.scale_b = (const float*)d_in[12]; p.w_out_b = (const float*)d_in[13]; p.rel_bias = (const float*)d_in[14]; p.final_norm = (const float*)d_in[15];
  p.out = (float*)d_out; p.ws = (unsigned char*)d_ws; p.probe = PROBE_PHASE; p.pad = 0;
  void* args[] = {&p};
  hipError_t e = hipLaunchCooperativeKernel((void*)fwd_mega, dim3(grid_blocks), dim3(512), args, LDS_BYTES, stream);
  if (e != hipSuccess) fprintf(stderr, "cooperative launch failed: %s (grid %d)\n", hipGetErrorString(e), grid_blocks);
}
```

```cpp
#include <hip/hip_runtime.h>
#include <hip/hip_cooperative_groups.h>
#include <cstdio>
#include <cstdint>
namespace cg = cooperative_groups;

#define LAS __attribute__((address_space(3)))
typedef unsigned short bf16_t;
typedef short bf16x8 __attribute__((ext_vector_type(8)));
typedef short s16x4 __attribute__((ext_vector_type(4)));
typedef float f32x4 __attribute__((ext_vector_type(4)));
typedef float f32x16 __attribute__((ext_vector_type(16)));
typedef unsigned u32x4 __attribute__((ext_vector_type(4)));
typedef unsigned u32x2 __attribute__((ext_vector_type(2)));

constexpr int T = 32768, L = 2048, D = 2048, DI = 4096;
constexpr float EPS = 1e-6f;
constexpr float LOG2E = 1.4426950408889634f;
constexpr int LDS_BYTES = 156 * 1024;
#ifndef PROBE_PHASE
#define PROBE_PHASE -1
#endif

constexpr size_t OFF_RQ = 0;
constexpr size_t OFF_RZ = 268435456;
constexpr size_t OFF_QL0 = 536870912;
constexpr size_t OFF_XQ = OFF_QL0 + 134217728;
constexpr size_t OFF_WOUTA = 805306368;
constexpr size_t OFF_WB = OFF_WOUTA + 16777216;
constexpr int LDH = 2112, LDWB = 2112;
constexpr size_t OFF_WU = OFF_WB + (size_t)8192 * LDWB * 2;
constexpr size_t OFF_WG = OFF_WU + 16777216;
constexpr size_t OFF_WOUTB = OFF_WG + 8388608;
constexpr size_t OFF_WUK = OFF_WOUTB + 16777216;
constexpr size_t OFF_WUV = OFF_WUK + 2097152;
constexpr size_t OFF_WA = OFF_WUV + 4194304;
constexpr size_t OFF_WAI = OFF_WA + (size_t)8192 * 2048;
constexpr size_t OFF_IDX = OFF_WA;
constexpr size_t OFF_CKVN = OFF_WA + 16777216;
constexpr size_t OFF_CKVR = OFF_WA + 39845888;
constexpr size_t OFF_QIDX = OFF_CKVR + 33554432;
constexpr size_t OFF_KIDX = OFF_QIDX + 67108864;
constexpr size_t OFF_WIDX = OFF_KIDX + 4194304;
constexpr size_t OFF_SS = OFF_WIDX + 2097152;
constexpr size_t OFF_BAR = OFF_SS + 3 * 131072;
constexpr size_t OFF_SMALL = OFF_BAR + 256;
constexpr int SM_KIDXN = 0, SM_KVN = 64, SM_RELB = 320, SM_BGRP = 1344, SM_SCALE = 5440, SM_FINAL = 9536, SM_TOTAL = 11584;
constexpr size_t WS_END = OFF_SMALL + (size_t)SM_TOTAL * 4;

struct Params {
  const float *x, *norm_a, *w_in_a, *kv_norm, *kidx_norm, *w_uk, *w_uv, *w_out_a, *norm_b, *w_in_b, *w_grp, *b_grp, *scale_b, *w_out_b, *rel_bias, *final_norm;
  float* out; unsigned char* ws; int probe; int pad;
};

__device__ __forceinline__ unsigned cvt_pk_bf16(float lo, float hi) { unsigned r; asm("v_cvt_pk_bf16_f32 %0, %1, %2" : "=v"(r) : "v"(lo), "v"(hi)); return r; }
__device__ __forceinline__ float bf2f(unsigned short b) { return __uint_as_float(((unsigned)b) << 16); }
__device__ __forceinline__ float bflo(unsigned w) { return __uint_as_float(w << 16); }
__device__ __forceinline__ float bfhi(unsigned w) { return __uint_as_float(w & 0xffff0000u); }
__device__ __forceinline__ u32x4 pack8(f32x4 a, f32x4 b) { u32x4 w; w[0] = cvt_pk_bf16(a[0], a[1]); w[1] = cvt_pk_bf16(a[2], a[3]); w[2] = cvt_pk_bf16(b[0], b[1]); w[3] = cvt_pk_bf16(b[2], b[3]); return w; }
__device__ __forceinline__ float sx(float v, int mask, int lane) { return __int_as_float(__builtin_amdgcn_ds_bpermute((lane ^ mask) << 2, __float_as_int(v))); }
typedef unsigned u32x2s __attribute__((ext_vector_type(2)));
__device__ __forceinline__ float pmax16(float x) { const u32x2s r = __builtin_amdgcn_permlane16_swap(__float_as_uint(x), __float_as_uint(x), false, false); return __builtin_amdgcn_fmed3f(__uint_as_float(r[0]), __uint_as_float(r[1]), __builtin_inff()); }
__device__ __forceinline__ float pmax32(float x) { const u32x2s r = __builtin_amdgcn_permlane32_swap(__float_as_uint(x), __float_as_uint(x), false, false); return __builtin_amdgcn_fmed3f(__uint_as_float(r[0]), __uint_as_float(r[1]), __builtin_inff()); }
__device__ __forceinline__ float psum16(float x) { const u32x2s r = __builtin_amdgcn_permlane16_swap(__float_as_uint(x), __float_as_uint(x), false, false); return __uint_as_float(r[0]) + __uint_as_float(r[1]); }
__device__ __forceinline__ float psum32(float x) { const u32x2s r = __builtin_amdgcn_permlane32_swap(__float_as_uint(x), __float_as_uint(x), false, false); return __uint_as_float(r[0]) + __uint_as_float(r[1]); }
template <int CTRL> __device__ __forceinline__ float dppf(float x) { return __int_as_float(__builtin_amdgcn_update_dpp(0, __float_as_int(x), CTRL, 0xf, 0xf, false)); }
__device__ __forceinline__ float vmin(float a, float b) { return __builtin_amdgcn_fmed3f(a, b, -__builtin_inff()); }
__device__ __forceinline__ float pmin16(float x) { const u32x2s r = __builtin_amdgcn_permlane16_swap(__float_as_uint(x), __float_as_uint(x), false, false); return vmin(__uint_as_float(r[0]), __uint_as_float(r[1])); }
__device__ __forceinline__ float pmin32(float x) { const u32x2s r = __builtin_amdgcn_permlane32_swap(__float_as_uint(x), __float_as_uint(x), false, false); return vmin(__uint_as_float(r[0]), __uint_as_float(r[1])); }
__device__ __forceinline__ float wave_sum(float s, int) { s += dppf<0x128>(s); s += dppf<0x124>(s); s += dppf<0x122>(s); s += dppf<0x121>(s); return psum32(psum16(s)); }
__device__ __forceinline__ float wave_max(float s) { s = __builtin_amdgcn_fmed3f(s, dppf<0x128>(s), __builtin_inff()); s = __builtin_amdgcn_fmed3f(s, dppf<0x124>(s), __builtin_inff()); s = __builtin_amdgcn_fmed3f(s, dppf<0x122>(s), __builtin_inff()); s = __builtin_amdgcn_fmed3f(s, dppf<0x121>(s), __builtin_inff()); return pmax32(pmax16(s)); }
__device__ __forceinline__ float wave_min(float s) { s = vmin(s, dppf<0x128>(s)); s = vmin(s, dppf<0x124>(s)); s = vmin(s, dppf<0x122>(s)); s = vmin(s, dppf<0x121>(s)); return pmin32(pmin16(s)); }
__device__ __forceinline__ float vmax(float a, float b) { return __builtin_amdgcn_fmed3f(a, b, __builtin_inff()); }
__device__ __forceinline__ float relu_i(float x) { return __int_as_float(max(__float_as_int(x), 0)); }
__device__ __forceinline__ float silu(float z) { return z / (1.f + __expf(-z)); }
__device__ __forceinline__ float silu_fast(float z) { return z * __builtin_amdgcn_rcpf(1.f + __builtin_amdgcn_exp2f(-1.4426950408889634f * z)); }

namespace g8 {
constexpr int BM = 256, BK = 64, HALF = 128, HTB = HALF * BK * 2, STAGE_BYTES = 8 * HTB, NXCD = 8, WGM = 2;
__device__ __forceinline__ int lds_byte(int r, int c) { const int st = (r >> 4) * 2 + (c >> 5), rr = r & 15, cc = c & 31, ob = rr * 64 + cc * 2; return st * 1024 + (ob ^ (((ob >> 9) & 1) << 5)); }
__device__ __forceinline__ void stage_rc(int b, int& R, int& C) { const int st = b / 1024, sb = b % 1024, swz = sb ^ (((sb >> 9) & 1) << 5); R = (st >> 1) * 16 + swz / 64; C = (st & 1) * 32 + (swz % 64) / 2; }
__device__ __forceinline__ int perm32(int rho) { const int n = rho >> 4, i = rho & 15; return 8 * (i >> 2) + 4 * n + (i & 3); }

struct GUnit { const char* A; const char* B; int pm, pn; };

struct Sched {
  int nM, nN, nwg, G, c;
  const char* A0; const char* A1; int pmSplit; size_t sAm, sAn;
  const char* B0; size_t sBn, sBg; int gshift; int anshift;
  __device__ __forceinline__ void init(int nM_, int nN_, int G_, int c_) { nM = nM_; nN = nN_; nwg = nM * nN; G = G_; c = c_; A1 = nullptr; pmSplit = 1 << 30; sAn = 0; sBg = 0; gshift = 0; anshift = 0; }
  __device__ __forceinline__ bool next(int i, GUnit& u) const {
    const int Lx = i * G + c; if (Lx >= nwg) return false;
    int wgid = Lx; { const int q = nwg / NXCD, r = nwg % NXCD, xcd = wgid % NXCD, off = wgid / NXCD; wgid = (xcd < r ? xcd * (q + 1) : r * (q + 1) + (xcd - r) * q) + off; }
    const int nig = WGM * nN, gid = wgid / nig, fm = gid * WGM, gsz = (nM - fm) < WGM ? (nM - fm) : WGM;
    u.pm = fm + ((wgid % nig) % gsz); u.pn = (wgid % nig) / gsz;
    u.A = (u.pm < pmSplit ? A0 + (size_t)u.pm * sAm : A1 + (size_t)(u.pm - pmSplit) * sAm) + (size_t)(u.pn >> anshift) * sAn;
    u.B = B0 + (size_t)u.pn * sBn + (size_t)(u.pm >> gshift) * sBg;
    return true;
  }
};

typedef int v8i __attribute__((ext_vector_type(8)));
__device__ __forceinline__ v8i cat8(bf16x8 a, bf16x8 b) { union { bf16x8 h[2]; v8i v; } u; u.h[0] = a; u.h[1] = b; return u.v; }
template <class Epi, bool FP8 = false, int BD = 0>
__device__ __forceinline__ void gemm_phase(LAS unsigned char* lds, const int K, const int lda, const int ldb, const Sched& S, const Epi& E) {
  int tid = threadIdx.x; asm volatile("" : "+v"(tid));
  const int wid = __builtin_amdgcn_readfirstlane(tid >> 6), lane = tid & 63, wr = wid >> 2, wc = wid & 3, fr = lane & 15, fq = lane >> 4;
  const int nt = K / BK;
  unsigned voffA, voffB;
  { int R, C; stage_rc(tid * 16, R, C); const int Rb = (R & ~31) + perm32(R & 31); voffA = (unsigned)(R * lda + C) * 2u; voffB = (unsigned)(Rb * ldb + C) * 2u; }
  const size_t p2A = (size_t)64 * lda * 2, p2B = (size_t)64 * ldb * 2;
  const size_t kstep = (size_t)(BK * 2);
  const size_t hstepA = (size_t)HALF * lda * 2, hstepB = (size_t)HALF * ldb * 2;
  const unsigned ldsw = (unsigned)wid * 1024u;
  const int aoff = lds_byte(wr * 64 + fr, fq * 8), boff = lds_byte(wc * 32 + fr, fq * 8);
#define G8_SA(b, h) (((b) * 2 + (h)) * HTB)
#define G8_SB(b, h) ((4 + (b) * 2 + (h)) * HTB)
#define G8_STAGE(bufoff, gbase, NM) do { _Pragma("unroll") for (int _i = 0; _i < 2; ++_i) { \
    const char* _b = (const char*)(gbase) + (_i ? p2##NM : (size_t)0); asm volatile("" : "+s"(_b));     \
    __builtin_amdgcn_global_load_lds((const unsigned*)(_b + voff##NM), (LAS unsigned*)(lds + (bufoff) + ldsw + _i * 8192), 16, 0, 0); } } while (0)
#define G8_LDA(dst, b, h) do { _Pragma("unroll") for (int m = 0; m < 4; ++m) { \
    if constexpr (FP8) dst##8[m] = cat8(*(const LAS bf16x8*)(lds + G8_SA(b, h) + aoff + m * 2048), *(const LAS bf16x8*)(lds + G8_SA(b, h) + aoff + m * 2048 + 1024)); \
    else { _Pragma("unroll") for (int k = 0; k < 2; ++k) dst[m][k] = *(const LAS bf16x8*)(lds + G8_SA(b, h) + aoff + m * 2048 + k * 1024); } } } while (0)
#define G8_LDB(dst, b, h) do { _Pragma("unroll") for (int n = 0; n < 2; ++n) { \
    if constexpr (FP8) dst##8[n] = cat8(*(const LAS bf16x8*)(lds + G8_SB(b, h) + boff + n * 2048), *(const LAS bf16x8*)(lds + G8_SB(b, h) + boff + n * 2048 + 1024)); \
    else { _Pragma("unroll") for (int k = 0; k < 2; ++k) dst[n][k] = *(const LAS bf16x8*)(lds + G8_SB(b, h) + boff + n * 2048 + k * 1024); } } } while (0)
#define G8_MMA(ai, bj, At, Bt) do { __builtin_amdgcn_s_setprio(1); _Pragma("unroll") for (int m = 0; m < 4; ++m) _Pragma("unroll") for (int n = 0; n < 2; ++n) { \
    if constexpr (FP8) acc[ai][bj][m][n] = __builtin_amdgcn_mfma_scale_f32_16x16x128_f8f6f4(Bt##8[n], At##8[m], acc[ai][bj][m][n], 0, 0, 0, 0, 0, 0); \
    else { _Pragma("unroll") for (int k = 0; k < 2; ++k) acc[ai][bj][m][n] = __builtin_amdgcn_mfma_f32_16x16x32_bf16(Bt[n][k], At[m][k], acc[ai][bj][m][n], 0, 0, 0); } } \
    __builtin_amdgcn_s_setprio(0); } while (0)
#define G8_WAIT_V(n) asm volatile("s_waitcnt vmcnt(" #n ")" ::: "memory")
#define G8_WAIT_L(n) asm volatile("s_waitcnt lgkmcnt(" #n ")" ::: "memory")
#define G8_BAR __builtin_amdgcn_s_barrier()
#define G8_SCHED __builtin_amdgcn_sched_barrier(0)
  GUnit cur, nxt; int ui = 0;
  if (!S.next(0, cur)) return;
  f32x4 acc[2][2][4][2];
#pragma unroll
  for (int a = 0; a < 2; ++a)
#pragma unroll
    for (int b = 0; b < 2; ++b)
#pragma unroll
      for (int m = 0; m < 4; ++m)
#pragma unroll
        for (int n = 0; n < 2; ++n) acc[a][b][m][n] = (f32x4){0.f, 0.f, 0.f, 0.f};
  bf16x8 At[4][2], B0[2][2], B1[2][2];
  v8i At8[4], B08[2], B18[2];
  const char* cA = cur.A; const char* cB = cur.B;
  G8_STAGE(G8_SB(0, 0), cB, B); G8_STAGE(G8_SB(0, 1), cB + hstepB, B); G8_STAGE(G8_SA(0, 0), cA, A); G8_STAGE(G8_SA(0, 1), cA + hstepA, A);
  if (wr == 1) G8_BAR;
  G8_WAIT_V(2); G8_BAR;
  G8_STAGE(G8_SB(1, 0), cB + kstep, B); G8_STAGE(G8_SA(1, 0), cA + kstep, A); G8_STAGE(G8_SB(1, 1), cB + hstepB + kstep, B);
  G8_WAIT_V(6); G8_BAR;
  for (;;) {
    const bool has_next = S.next(ui + 1, nxt);
    const char* nA = has_next ? nxt.A : cA; const char* nB = has_next ? nxt.B : cB;
    for (int t = 0; t < nt; t += 2) {
      const bool last = (t == nt - 2);
      const char* a1 = cA + (size_t)(t + 1) * kstep + hstepA;
      const char* a2 = last ? nA : cA + (size_t)(t + 2) * kstep; const char* b2 = last ? nB : cB + (size_t)(t + 2) * kstep;
      const char* a3 = a2 + kstep; const char* b3 = b2 + kstep;
      asm volatile("" : "+s"(a1), "+s"(a2), "+s"(b2), "+s"(a3), "+s"(b3));
      G8_LDB(B0, 0, 0); G8_LDB(B1, 0, 1); G8_SCHED; G8_LDA(At, 0, 0); G8_STAGE(G8_SA(1, 1), a1, A);
      const bool d0a = (BD == 0) || (BD == 1 && t < (nt >> 1)) || (BD == 2 && !(cur.pn & 1));
      const bool d1a = (BD == 0) || (BD == 1 && t >= (nt >> 1)) || (BD == 2 && !(cur.pn & 1));
      const bool d0b = (BD == 0) || (BD == 1 && t < (nt >> 1)) || (BD == 2 && (cur.pn & 1));
      const bool d1b = (BD == 0) || (BD == 1 && t >= (nt >> 1)) || (BD == 2 && (cur.pn & 1));
      G8_WAIT_V(8); G8_WAIT_L(0); G8_BAR; if (d0a) G8_MMA(0, 0, At, B0); if (d1a) G8_MMA(0, 1, At, B1); G8_BAR; G8_SCHED;
      G8_LDA(At, 0, 1); G8_STAGE(G8_SB(0, 0), b2, B); G8_STAGE(G8_SB(0, 1), b2 + hstepB, B); G8_STAGE(G8_SA(0, 0), a2, A);
      G8_WAIT_V(8); G8_WAIT_L(0); G8_BAR; if (d0a) G8_MMA(1, 0, At, B0); if (d1a) G8_MMA(1, 1, At, B1); G8_BAR; G8_SCHED;
      G8_LDB(B0, 1, 0); G8_LDB(B1, 1, 1); G8_SCHED; G8_LDA(At, 1, 0); G8_STAGE(G8_SA(0, 1), a2 + hstepA, A);
      G8_WAIT_V(8); G8_WAIT_L(0); G8_BAR; if (d0b) G8_MMA(0, 0, At, B0); if (d1b) G8_MMA(0, 1, At, B1); G8_BAR; G8_SCHED;
      G8_LDA(At, 1, 1); G8_STAGE(G8_SB(1, 0), b3, B); G8_STAGE(G8_SB(1, 1), b3 + hstepB, B); G8_STAGE(G8_SA(1, 0), a3, A);
      G8_WAIT_V(8); G8_WAIT_L(0); G8_BAR; if (d0b) G8_MMA(1, 0, At, B0); if (d1b) G8_MMA(1, 1, At, B1); G8_BAR; G8_SCHED;
    }
    if (wr == 0) G8_BAR;
    {
      int t2 = threadIdx.x; asm volatile("" : "+v"(t2));
      const int w2 = __builtin_amdgcn_readfirstlane(t2 >> 6), l2 = t2 & 63;
      E(acc, cur, w2 >> 2, w2 & 3, l2 & 15, l2 >> 4); }
    if (!has_next) break;
#pragma unroll
    for (int a = 0; a < 2; ++a)
#pragma unroll
      for (int b = 0; b < 2; ++b)
#pragma unroll
        for (int m = 0; m < 4; ++m)
#pragma unroll
          for (int n = 0; n < 2; ++n) acc[a][b][m][n] = (f32x4){0.f, 0.f, 0.f, 0.f};
    cur = nxt; cA = nA; cB = nB; ++ui;
    if (wr == 1) G8_BAR;
  }
  G8_WAIT_V(0);
  G8_BAR;
#undef G8_SA
#undef G8_SB
#undef G8_STAGE
#undef G8_LDA
#undef G8_LDB
#undef G8_MMA
#undef G8_WAIT_V
#undef G8_WAIT_L
#undef G8_BAR
#undef G8_SCHED
}

typedef f32x4 Acc[2][2][4][2];

struct EpiProjA {
  const float* ss0; bf16_t* q; bf16_t* z; float* ckv; bf16_t* qidx; bf16_t* kidx; float* widx; const float* kg; int pnoff; float osc;
  __device__ __forceinline__ void operator()(const Acc& acc, const GUnit& u, int wr, int wc, int fr, int fq) const {
    const int row0 = u.pm * 256 + wr * 64 + fr, pn = u.pn + pnoff;
#pragma unroll
    for (int ai = 0; ai < 2; ++ai)
#pragma unroll
      for (int m = 0; m < 4; ++m) {
        const int row = row0 + ai * 128 + m * 16;
        const float rs = rsqrtf(ss0[row] * (1.f / 2048.f) + EPS) * osc;
        if (pn < 32) {
          unsigned char* base = (unsigned char*)(pn < 16 ? q : z) + (size_t)row * 4096 + (pn & 15) * 256 + wc * 32 + 8 * fq;
#pragma unroll
          for (int bj = 0; bj < 2; ++bj) { const f32x4 a = acc[ai][bj][m][0] * rs, b = acc[ai][bj][m][1] * rs; u32x2 w;
            w[0] = __builtin_amdgcn_cvt_pk_fp8_f32(a[0], a[1], 0, false); w[0] = __builtin_amdgcn_cvt_pk_fp8_f32(a[2], a[3], w[0], true);
            w[1] = __builtin_amdgcn_cvt_pk_fp8_f32(b[0], b[1], 0, false); w[1] = __builtin_amdgcn_cvt_pk_fp8_f32(b[2], b[3], w[1], true);
            *(u32x2*)(base + bj * 128) = w; }
        } else if (pn == 32) {
          float* base = ckv + (size_t)row * 256 + wc * 32 + 8 * fq;
#pragma unroll
          for (int bj = 0; bj < 2; ++bj) { *(f32x4*)(base + bj * 128) = acc[ai][bj][m][0] * rs; *(f32x4*)(base + bj * 128 + 4) = acc[ai][bj][m][1] * rs; }
        } else if (pn < 37) {
          bf16_t* base = qidx + (size_t)row * 1024 + (pn - 33) * 256 + wc * 32 + 8 * fq;
#pragma unroll
          for (int bj = 0; bj < 2; ++bj) *(u32x4*)(base + bj * 128) = pack8(acc[ai][bj][m][0] * rs, acc[ai][bj][m][1] * rs);
        } else {
          if (wc == 0) {
            f32x4 v[2][2]; float s = 0.f;
#pragma unroll
            for (int bj = 0; bj < 2; ++bj)
#pragma unroll
              for (int n = 0; n < 2; ++n) { v[bj][n] = acc[ai][bj][m][n] * rs; s += v[bj][n][0] * v[bj][n][0] + v[bj][n][1] * v[bj][n][1] + v[bj][n][2] * v[bj][n][2] + v[bj][n][3] * v[bj][n][3]; }
            s = psum32(psum16(s));
            const float kr = rsqrtf(s * (1.f / 64.f) + EPS);
#pragma unroll
            for (int bj = 0; bj < 2; ++bj) {
              const f32x4 g0 = *(const f32x4*)(kg + 32 * bj + 8 * fq), g1 = *(const f32x4*)(kg + 32 * bj + 8 * fq + 4);
              *(u32x4*)(kidx + ((size_t)(row >> 5) * 4 + 2 * bj + (fq >> 1)) * 512 + ((fq & 1) * 32 + (row & 31)) * 8) = pack8(v[bj][0] * kr * g0, v[bj][1] * kr * g1);
            }
          } else if (wc == 1 && fq < 2) {
            float* base = widx + (size_t)row * 16 + 8 * fq;
            *(f32x4*)(base) = acc[ai][0][m][0] * (rs * 0.25f); *(f32x4*)(base + 4) = acc[ai][0][m][1] * (rs * 0.25f);
          }
        }
      }
  }
};

struct EpiBf16 {
  bf16_t* O0; bf16_t* O1; int nsplit; int ld; const float* ss;
  __device__ __forceinline__ void operator()(const Acc& acc, const GUnit& u, int wr, int wc, int fr, int fq) const {
    const int row0 = u.pm * 256 + wr * 64 + fr;
    bf16_t* ob = (u.pn < nsplit ? O0 + (size_t)u.pn * 256 : O1 + (size_t)(u.pn - nsplit) * 256) + wc * 32 + 8 * fq;
#pragma unroll
    for (int ai = 0; ai < 2; ++ai)
#pragma unroll
      for (int m = 0; m < 4; ++m) {
        const int row = row0 + ai * 128 + m * 16;
        const float rs = ss ? rsqrtf(ss[row] * (1.f / 2048.f) + EPS) : 1.f;
#pragma unroll
        for (int bj = 0; bj < 2; ++bj) *(u32x4*)(ob + (size_t)row * ld + bj * 128) = pack8(acc[ai][bj][m][0] * rs, acc[ai][bj][m][1] * rs);
      }
  }
};

struct EpiQlat {
  unsigned char* Q0; float osc;
  __device__ __forceinline__ void operator()(const Acc& acc, const GUnit& u, int wr, int wc, int fr, int fq) const {
    const int row0 = u.pm * 256 + wr * 64 + fr;
    unsigned char* ob = Q0 + (size_t)u.pn * 256 + wc * 32 + 8 * fq;
#pragma unroll
    for (int ai = 0; ai < 2; ++ai)
#pragma unroll
      for (int m = 0; m < 4; ++m) {
        const int row = row0 + ai * 128 + m * 16;
#pragma unroll
        for (int bj = 0; bj < 2; ++bj) { const f32x4 a = acc[ai][bj][m][0] * osc, b = acc[ai][bj][m][1] * osc; u32x2 w;
          w[0] = __builtin_amdgcn_cvt_pk_fp8_f32(a[0], a[1], 0, false); w[0] = __builtin_amdgcn_cvt_pk_fp8_f32(a[2], a[3], w[0], true);
          w[1] = __builtin_amdgcn_cvt_pk_fp8_f32(b[0], b[1], 0, false); w[1] = __builtin_amdgcn_cvt_pk_fp8_f32(b[2], b[3], w[1], true);
          *(u32x2*)(ob + (size_t)row * 8192 + bj * 128) = w; }
      }
  }
};

struct EpiGate {
  unsigned char* Y; const unsigned char* Z; float osc;
  __device__ __forceinline__ void operator()(const Acc& acc, const GUnit& u, int wr, int wc, int fr, int fq) const {
    const int row0 = u.pm * 256 + wr * 64 + fr; const int col0 = u.pn * 256 + wc * 32 + 8 * fq;
#pragma unroll
    for (int ai = 0; ai < 2; ++ai)
#pragma unroll
      for (int m = 0; m < 4; ++m) {
        const size_t off = (size_t)(row0 + ai * 128 + m * 16) * 4096 + col0;
#pragma unroll
        for (int bj = 0; bj < 2; ++bj) {
          const u32x2 zw = *(const u32x2*)(Z + off + bj * 128);
          typedef float f32x2v __attribute__((ext_vector_type(2)));
          const f32x2v z0 = __builtin_amdgcn_cvt_pk_f32_fp8(zw[0], false), z1 = __builtin_amdgcn_cvt_pk_f32_fp8(zw[0], true), z2 = __builtin_amdgcn_cvt_pk_f32_fp8(zw[1], false), z3 = __builtin_amdgcn_cvt_pk_f32_fp8(zw[1], true);
          f32x4 a = acc[ai][bj][m][0] * osc, b = acc[ai][bj][m][1] * osc;
          a[0] *= silu_fast(z0[0]); a[1] *= silu_fast(z0[1]); a[2] *= silu_fast(z1[0]); a[3] *= silu_fast(z1[1]);
          b[0] *= silu_fast(z2[0]); b[1] *= silu_fast(z2[1]); b[2] *= silu_fast(z3[0]); b[3] *= silu_fast(z3[1]);
          u32x2 w; w[0] = __builtin_amdgcn_cvt_pk_fp8_f32(a[0], a[1], 0, false); w[0] = __builtin_amdgcn_cvt_pk_fp8_f32(a[2], a[3], w[0], true);
          w[1] = __builtin_amdgcn_cvt_pk_fp8_f32(b[0], b[1], 0, false); w[1] = __builtin_amdgcn_cvt_pk_fp8_f32(b[2], b[3], w[1], true);
          *(u32x2*)(Y + off + bj * 128) = w;
        }
      }
  }
};

struct EpiRes {
  const float* R; const bf16_t* RB; int ldrb; float* H; bf16_t* HB; int ldhb; float* ss; float osc;
  __device__ __forceinline__ void operator()(const Acc& acc, const GUnit& u, int wr, int wc, int fr, int fq) const {
    const int row0 = u.pm * 256 + wr * 64 + fr; const int col0 = u.pn * 256 + wc * 32 + 8 * fq;
#pragma unroll
    for (int ai = 0; ai < 2; ++ai)
#pragma unroll
      for (int m = 0; m < 4; ++m) {
        const int row = row0 + ai * 128 + m * 16; const size_t off = (size_t)row * 2048 + col0; float s = 0.f;
#pragma unroll
        for (int bj = 0; bj < 2; ++bj) {
          f32x4 r0, r1;
          if (R) { r0 = *(const f32x4*)(R + off + bj * 128); r1 = *(const f32x4*)(R + off + bj * 128 + 4); }
          else { const u32x4 rw = *(const u32x4*)(RB + (size_t)row * ldrb + col0 + bj * 128);
            r0 = (f32x4){bflo(rw[0]), bfhi(rw[0]), bflo(rw[1]), bfhi(rw[1])}; r1 = (f32x4){bflo(rw[2]), bfhi(rw[2]), bflo(rw[3]), bfhi(rw[3])}; }
          const f32x4 h0 = r0 + acc[ai][bj][m][0] * osc, h1 = r1 + acc[ai][bj][m][1] * osc;
          if (H) { *(f32x4*)(H + off + bj * 128) = h0; *(f32x4*)(H + off + bj * 128 + 4) = h1; }
          if (HB) *(u32x4*)(HB + (size_t)row * ldhb + col0 + bj * 128) = pack8(h0, h1);
          s += h0[0] * h0[0] + h0[1] * h0[1] + h0[2] * h0[2] + h0[3] * h0[3] + h1[0] * h1[0] + h1[1] * h1[1] + h1[2] * h1[2] + h1[3] * h1[3];
        }
        s = psum32(psum16(s));
        if (fq == 0) atomicAdd(ss + row, s);
      }
  }
};
}

struct CmA { __device__ __forceinline__ int operator()(int n) const {
  if (n < 4096) return n;
  if (n < 8192) return 5456 + (n - 4096);
  if (n < 8448) return 4096 + (n - 8192);
  if (n < 9472) return 4352 + (n - 8448);
  const int c = n - 9472;
  if (c < 32) return 5376 + c;
  if (c < 48) return 5440 + (c - 32);
  if (c >= 128 && c < 160) return 5376 + 32 + (c - 128);
  return -1; } };
struct CmAI { __device__ __forceinline__ int operator()(int n) const { return CmA{}(n + 8192); } };
struct CmOff { int off; __device__ __forceinline__ int operator()(int n) const { return n + off; } };

template <class CM, bool FP8 = false>
__device__ __forceinline__ void tconv_tile(bf16_t* dst, int ldD, const float* src, int ldS, int kt, int np, const float* gk, CM cm, float* tl, int tid, float wsc = 1.f) {
  {
    { const int c = tid & 63, r = tid >> 6; const int sc0 = cm(np * 128 + c), sc1 = cm(np * 128 + 64 + c);
      float v0[8], v1[8];
#pragma unroll
      for (int pass = 0; pass < 8; ++pass) { const int k = kt * 64 + pass * 8 + r; const float g = (gk ? gk[k] : 1.f) * wsc;
        v0[pass] = (sc0 >= 0) ? src[(size_t)k * ldS + sc0] * g : 0.f; v1[pass] = (sc1 >= 0) ? src[(size_t)k * ldS + sc1] * g : 0.f; }
#pragma unroll
      for (int pass = 0; pass < 8; ++pass) { tl[(pass * 8 + r) * 129 + c] = v0[pass]; tl[(pass * 8 + r) * 129 + 64 + c] = v1[pass]; } }
    __syncthreads();
#pragma unroll
    for (int hf = 0; hf < 2; ++hf) { const int nl = hf * 64 + (tid >> 3), kc = tid & 7; float v[8];
#pragma unroll
      for (int j = 0; j < 8; ++j) v[j] = tl[(kc * 8 + j) * 129 + nl];
      if constexpr (FP8) {
        u32x2 w; w[0] = __builtin_amdgcn_cvt_pk_fp8_f32(v[0], v[1], 0, false); w[0] = __builtin_amdgcn_cvt_pk_fp8_f32(v[2], v[3], w[0], true);
        w[1] = __builtin_amdgcn_cvt_pk_fp8_f32(v[4], v[5], 0, false); w[1] = __builtin_amdgcn_cvt_pk_fp8_f32(v[6], v[7], w[1], true);
        *(u32x2*)((unsigned char*)dst + (size_t)(np * 128 + nl) * ldD + kt * 64 + kc * 8) = w;
      } else {
      u32x4 w; w[0] = cvt_pk_bf16(v[0], v[1]); w[1] = cvt_pk_bf16(v[2], v[3]); w[2] = cvt_pk_bf16(v[4], v[5]); w[3] = cvt_pk_bf16(v[6], v[7]);
      *(u32x4*)(dst + (size_t)(np * 128 + nl) * ldD + kt * 64 + kc * 8) = w; } }
    __syncthreads();
  }
}
template <class CM, bool FP8 = false>
__device__ __forceinline__ void tconv(bf16_t* dst, int ldD, const float* src, int ldS, int Ktiles, int Ntiles, const float* gk, CM cm, float* tl, int bid, int nb, float wsc = 1.f) {
  int tid = threadIdx.x; asm volatile("" : "+v"(tid));
  const int Np = Ntiles >> 1;
  for (int tile = bid; tile < Ktiles * Np; tile += nb) tconv_tile<CM, FP8>(dst, ldD, src, ldS, tile / Np, tile % Np, gk, cm, tl, tid, wsc);
}

__device__ __forceinline__ void p0_prep(const Params& p, unsigned char* lds, int bid, int nb) {
  int tid = threadIdx.x; asm volatile("" : "+v"(tid));
  const int lane = tid & 63, wid = tid >> 6;
  float* tl = (float*)lds;
  unsigned char* ws = p.ws;
  { bf16_t* xb = (bf16_t*)(ws + OFF_QL0); unsigned char* xq = ws + OFF_XQ; float* ss0 = (float*)(ws + OFF_SS);
    for (int row = bid * 8 + wid; row < T; row += nb * 8) {
      const f32x4* src = (const f32x4*)(p.x + (size_t)row * D); float s = 0.f;
#pragma unroll
      for (int j = 0; j < 8; ++j) { const f32x4 v = src[lane + 64 * j]; s += v[0] * v[0] + v[1] * v[1] + v[2] * v[2] + v[3] * v[3];
        u32x2 o; o[0] = cvt_pk_bf16(v[0], v[1]); o[1] = cvt_pk_bf16(v[2], v[3]); *(u32x2*)(xb + (size_t)row * D + (lane + 64 * j) * 4) = o;
        unsigned q8 = __builtin_amdgcn_cvt_pk_fp8_f32(v[0], v[1], 0, false); q8 = __builtin_amdgcn_cvt_pk_fp8_f32(v[2], v[3], q8, true); *(unsigned*)(xq + (size_t)row * D + (lane + 64 * j) * 4) = q8; }
      s = wave_sum(s, lane); if (lane == 0) ss0[row] = s;
    }
    for (int i = bid * 512 + tid; i < 2 * T; i += nb * 512) ss0[T + i] = 0.f;
    { float* sm = (float*)(ws + OFF_SMALL);
      for (int i = bid * 512 + tid; i < SM_TOTAL; i += nb * 512) {
        float v;
        if (i < SM_KVN) v = p.kidx_norm[i]; else if (i < SM_RELB) v = p.kv_norm[i - SM_KVN]; else if (i < SM_BGRP) v = p.rel_bias[i - SM_RELB];
        else if (i < SM_SCALE) v = p.b_grp[i - SM_BGRP]; else if (i < SM_FINAL) v = p.scale_b[i - SM_SCALE]; else v = p.final_norm[i - SM_FINAL];
        sm[i] = v; } } }
  tconv<CmA, true>((bf16_t*)(ws + OFF_WA), 2048, p.w_in_a, 9552, 32, 128, p.norm_a, CmA{}, tl, bid, nb, 64.f);
  tconv((bf16_t*)(ws + OFF_WAI), 2048, p.w_in_a, 9552, 32, 24, p.norm_a, CmAI{}, tl, bid, nb);
  tconv<CmOff, true>((bf16_t*)(ws + OFF_WOUTA), 4096, p.w_out_a, 2048, 64, 32, nullptr, CmOff{0}, tl, bid, nb, 64.f);
  tconv((bf16_t*)(ws + OFF_WB) + (size_t)4096 * LDWB, LDWB, p.w_in_b, 8192, 32, 64, p.norm_b, CmOff{4096}, tl, bid, nb);
  for (int it = bid; it < 512; it += nb) { const int g = it >> 7, rem = it & 127;
    tconv_tile((bf16_t*)(ws + OFF_WG) + (size_t)g * 1048576, 1024, p.w_grp + (size_t)g * 1048576, 1024, rem >> 3, rem & 7, nullptr, CmOff{0}, tl, tid); }
  tconv((bf16_t*)(ws + OFF_WOUTB), 4096, p.w_out_b, 2048, 64, 32, nullptr, CmOff{0}, tl, bid, nb);
  for (int it = bid; it < 128; it += nb) {
    const int h = it >> 2, pair = h >> 1, hh = h & 1;
    tconv_tile<CmOff, true>((bf16_t*)(ws + OFF_WUV + (size_t)pair * 131072 + (size_t)hh * 128 * 512 + hh * 256), 512, p.w_uv + h * 128, 4096, it & 3, 0, nullptr, CmOff{0}, tl, tid, 16.f);
  }
  {
    unsigned char* wv = ws + OFF_WUV;
    for (int i = bid * 512 + tid; i < 32 * 128 * 16; i += nb * 512) {
      const int piece = i & 15, r = (i >> 4) & 127, ph = i >> 11; const int pair = ph >> 1, hh = ph & 1;
      *(u32x4*)(wv + (size_t)pair * 131072 + (size_t)(hh * 128 + r) * 512 + (1 - hh) * 256 + piece * 16) = (u32x4){0u, 0u, 0u, 0u};
    } }
  {
    bf16_t* wu = (bf16_t*)(ws + OFF_WU);
    for (int i = bid * 512 + tid; i < 4 * 2048 * 256; i += nb * 512) {
      const int p4 = i & 255, k = (i >> 8) & 2047, g = i >> 19;
      const f32x4 v = *(const f32x4*)(p.w_in_b + (size_t)k * 8192 + g * 1024 + p4 * 4) * p.norm_b[k];
      u32x2 o; o[0] = cvt_pk_bf16(v[0], v[1]); o[1] = cvt_pk_bf16(v[2], v[3]); *(u32x2*)(wu + (size_t)g * 2097152 + (size_t)k * 1024 + p4 * 4) = o;
    } }
  {
    unsigned char* wk = ws + OFF_WUK;
    for (int i = bid * 512 + tid; i < 16 * 512 * 64; i += nb * 512) {
      const int k4 = i & 63, n = (i >> 6) & 511, pr = i >> 15; const int hh = n >> 8, c = n & 255;
      unsigned w = 0u;
      if ((k4 >> 5) == hh) { const f32x4 v = *(const f32x4*)(p.w_uk + (size_t)c * 4096 + (2 * pr + hh) * 128 + (k4 & 31) * 4) * 16.f;
        w = __builtin_amdgcn_cvt_pk_fp8_f32(v[0], v[1], 0, false); w = __builtin_amdgcn_cvt_pk_fp8_f32(v[2], v[3], w, true); }
      *(unsigned*)(wk + (size_t)pr * 131072 + (size_t)n * 256 + k4 * 4) = w;
    } }
}

__device__ __forceinline__ void p3_ckvnorm(const Params& p, int bid, int nb) {
  int tid = threadIdx.x; asm volatile("" : "+v"(tid));
  const int lane = tid & 63, wid = tid >> 6;
  const float* cr = (const float*)(p.ws + OFF_CKVR); bf16_t* cn = (bf16_t*)(p.ws + OFF_CKVN);
  const f32x4 g = *(const f32x4*)((const float*)(p.ws + OFF_SMALL) + SM_KVN + lane * 4);
  for (int row = bid * 8 + wid; row < T; row += nb * 8) {
    const f32x4 v = *(const f32x4*)(cr + (size_t)row * 256 + lane * 4);
    float s = v[0] * v[0] + v[1] * v[1] + v[2] * v[2] + v[3] * v[3]; s = wave_sum(s, lane);
    const float r = rsqrtf(s * (1.f / 256.f) + EPS);
    u32x2 o; o[0] = cvt_pk_bf16(v[0] * r * g[0], v[1] * r * g[1]); o[1] = cvt_pk_bf16(v[2] * r * g[2], v[3] * r * g[3]);
    *(u32x2*)(cn + (size_t)row * 256 + lane * 4) = o;
  }
}

__device__ __forceinline__ void p3_indexer(const Params& p, unsigned char* lds, int bid, int nb, int rep_sc, int rep_sel) {
  float* sc = (float*)lds;
  const bf16_t* qidx = (const bf16_t*)(p.ws + OFF_QIDX); const bf16_t* kidx = (const bf16_t*)(p.ws + OFF_KIDX); const float* widx = (const float*)(p.ws + OFF_WIDX);
  unsigned short* idxo = (unsigned short*)(p.ws + OFF_IDX);
  int tid = threadIdx.x; asm volatile("" : "+v"(tid));
  const int lane = tid & 63, wid = tid >> 6, h = lane >> 5, l31 = lane & 31;
  for (int round = 0; round * nb + bid < T / 16; ++round) {
    const int item = round * nb + bid;
    const int b = item & 15; int tile = item >> 4; { const int r16 = tile >> 4, j = tile & 15; tile = r16 * 16 + ((r16 & 1) ? 15 - j : j); }
    const int t0 = tile * 16;
    if (t0 < 256) {
      const int tok = tid >> 5, j0 = (tid & 31) * 8, t = t0 + tok;
      unsigned short v[8];
#pragma unroll
      for (int j = 0; j < 8; ++j) v[j] = (unsigned short)((j0 + j <= t) ? (j0 + j) : 0);
      u32x4 w; w[0] = v[0] | ((unsigned)v[1] << 16); w[1] = v[2] | ((unsigned)v[3] << 16); w[2] = v[4] | ((unsigned)v[5] << 16); w[3] = v[6] | ((unsigned)v[7] << 16);
      *(u32x4*)(idxo + (size_t)(b * L + t) * 256 + j0) = w;
      continue;
    }
    for (int rsc = 0; rsc < rep_sc; ++rsc) {
      const int tok = l31 >> 4, head = l31 & 15;
      const bf16_t* arow = qidx + (size_t)(b * L + t0 + 2 * wid + tok) * 1024 + head * 64 + 8 * h;
      bf16x8 aq[4];
#pragma unroll
      for (int ks = 0; ks < 4; ++ks) aq[ks] = *(const bf16x8*)(arow + 16 * ks);
      float wv[16];
#pragma unroll
      for (int tk = 0; tk < 2; ++tk) {
        const float* wp = widx + (size_t)(b * L + t0 + 2 * wid + tk) * 16 + 4 * h;
        const f32x4 w0 = *(const f32x4*)(wp), w1 = *(const f32x4*)(wp + 8);
#pragma unroll
        for (int i = 0; i < 4; ++i) { wv[tk * 8 + i] = w0[i] * 0.125f; wv[tk * 8 + 4 + i] = w1[i] * 0.125f; }
      }
      const unsigned char* kb = (const unsigned char*)(kidx + (size_t)b * 64 * 2048) + tid * 16;
      LAS unsigned char* stgb = (LAS unsigned char*)lds + 131072;
      const int nkt = ((t0 + 15) >> 5) + 1, ngr = (nkt + 1) >> 1;
      u32x4 sv = *(const u32x4*)(kb);
      *(LAS u32x4*)(stgb + tid * 16) = sv;
      if (ngr > 1) sv = *(const u32x4*)(kb + 8192);
      __syncthreads();
      for (int gr = 0; gr < ngr; ++gr) {
        if (gr + 1 < ngr) *(LAS u32x4*)(stgb + ((gr + 1) & 1) * 8192 + tid * 16) = sv;
        if (gr + 2 < ngr) sv = *(const u32x4*)(kb + (size_t)(gr + 2) * 8192);
        const LAS unsigned char* bb = stgb + (gr & 1) * 8192 + lane * 16;
#pragma unroll
        for (int q = 0; q < 2; ++q) {
          f32x16 acc;
#pragma unroll
          for (int i = 0; i < 16; ++i) acc[i] = 0.f;
#pragma unroll
          for (int ks = 0; ks < 4; ++ks) { const bf16x8 bfr = *(const LAS bf16x8*)(bb + q * 4096 + ks * 1024); acc = __builtin_amdgcn_mfma_f32_32x32x16_bf16(aq[ks], bfr, acc, 0, 0, 0); }
          float s0 = 0.f, s1 = 0.f;
#pragma unroll
          for (int i = 0; i < 8; ++i) { s0 += wv[i] * relu_i(acc[i]); s1 += wv[8 + i] * relu_i(acc[8 + i]); }
          s0 = psum32(s0); s1 = psum32(s1);
          sc[(2 * wid + h) * 2048 + 32 * (2 * gr + q) + l31] = h ? s1 : s0;
        }
        __syncthreads();
      }
    }
    __syncthreads();
    LAS unsigned* hist = (LAS unsigned*)((LAS unsigned char*)lds + 131072) + wid * 256;
    LAS unsigned* cand = (LAS unsigned*)((LAS unsigned char*)lds + 131072 + 8192) + wid * 128;
    for (int rsel = 0; rsel < rep_sel; ++rsel)
    for (int qq = 0; qq < 2; ++qq) {
      const int qi = 2 * wid + qq, t = t0 + qi;
      float v[32];
#pragma unroll
      for (int j = 0; j < 32; ++j) v[j] = sc[qi * 2048 + lane + 64 * j];
      float mn = 3.0e38f, mx = -3.0e38f;
#pragma unroll
      for (int j = 0; j < 32; ++j) { const bool valid = (lane + 64 * j) <= t; mn = valid ? fminf(mn, v[j]) : mn; mx = valid ? fmaxf(mx, v[j]) : mx; }
      mn = wave_min(mn); mx = wave_max(mx);
      const float scale = (mx > mn) ? 255.f / (mx - mn) : 0.f;
      *(LAS u32x4*)(hist + lane * 4) = (u32x4){0u, 0u, 0u, 0u};
      asm volatile("" ::: "memory");
#pragma unroll
      for (int j = 0; j < 32; ++j) { const bool valid = (lane + 64 * j) <= t; const int bin = min((int)((v[j] - mn) * scale), 255);
        if (valid) __hip_atomic_fetch_add(hist + bin, 1u, __ATOMIC_RELAXED, __HIP_MEMORY_SCOPE_WORKGROUP); }
      asm volatile("s_waitcnt lgkmcnt(0)" ::: "memory");
      const u32x4 h4 = *(const LAS u32x4*)(hist + lane * 4);
      const int tot = (int)(h4[0] + h4[1] + h4[2] + h4[3]);
      int px = tot;
      px += __builtin_amdgcn_update_dpp(0, px, 0x111, 0xf, 0xf, true); px += __builtin_amdgcn_update_dpp(0, px, 0x112, 0xf, 0xf, true);
      px += __builtin_amdgcn_update_dpp(0, px, 0x114, 0xf, 0xf, true); px += __builtin_amdgcn_update_dpp(0, px, 0x118, 0xf, 0xf, true);
      const int rt0 = __builtin_amdgcn_readlane(px, 15), rt1 = __builtin_amdgcn_readlane(px, 31), rt2 = __builtin_amdgcn_readlane(px, 47), rt3 = __builtin_amdgcn_readlane(px, 63);
      const int pre = px + (lane >= 16 ? rt0 : 0) + (lane >= 32 ? rt1 : 0) + (lane >= 48 ? rt2 : 0);
      const int suf = (rt0 + rt1 + rt2 + rt3) - pre + tot;
      const int S3 = suf - tot + (int)h4[3], S2 = S3 + (int)h4[2], S1 = S2 + (int)h4[1], S0 = S1 + (int)h4[0];
      const unsigned long long bm = __ballot(S0 >= 256);
      const int lstar = 63 - __clzll(bm);
      const int myB = S3 >= 256 ? 3 : (S2 >= 256 ? 2 : (S1 >= 256 ? 1 : 0));
      const int mySB = S3 >= 256 ? S3 : (S2 >= 256 ? S2 : (S1 >= 256 ? S1 : S0));
      const int myh = (int)(S3 >= 256 ? h4[3] : (S2 >= 256 ? h4[2] : (S1 >= 256 ? h4[1] : h4[0])));
      const int B = lstar * 4 + __builtin_amdgcn_readlane(myB, lstar);
      const int m = __builtin_amdgcn_readlane(myh, lstar);
      const int c_hi = __builtin_amdgcn_readlane(mySB, lstar) - m, need = 256 - c_hi;
      unsigned short* op = idxo + (size_t)(b * L + t) * 256;
      int base = 0, cbn = 0;
#pragma unroll
      for (int j = 0; j < 32; ++j) {
        const int e = lane + 64 * j; const bool valid = e <= t; const int bin = min((int)((v[j] - mn) * scale), 255);
        const bool hi = valid && bin > B, eq = valid && bin == B;
        const unsigned long long hm = __ballot(hi), em = __ballot(eq);
        const int pos = base + (int)__builtin_amdgcn_mbcnt_hi((unsigned)(hm >> 32), __builtin_amdgcn_mbcnt_lo((unsigned)hm, 0u));
        const int cpos = cbn + (int)__builtin_amdgcn_mbcnt_hi((unsigned)(em >> 32), __builtin_amdgcn_mbcnt_lo((unsigned)em, 0u));
        if (hi && pos < 256) op[pos] = (unsigned short)e;
        if (eq && cpos < 64) { const unsigned bits = __float_as_uint(v[j]); cand[2 * cpos] = bits ^ ((bits >> 31) ? 0xFFFFFFFFu : 0x80000000u); cand[2 * cpos + 1] = (unsigned)e; }
        base += __popcll(hm); cbn += __popcll(em);
      }
      if (m <= 64) {
        asm volatile("s_waitcnt lgkmcnt(0)" ::: "memory");
        const unsigned ck = (lane < m) ? cand[2 * lane] : 0u, ce = (lane < m) ? cand[2 * lane + 1] : 0xffffu;
        int rank = 0;
        for (int jj = 0; jj < m; ++jj) { const unsigned kj = __builtin_amdgcn_readlane(ck, jj), ej = __builtin_amdgcn_readlane(ce, jj); rank += (kj > ck || (kj == ck && ej < ce)) ? 1 : 0; }
        const bool selc = (lane < m) && (rank < need);
        const unsigned long long sm = __ballot(selc);
        const int pos = c_hi + (int)__builtin_amdgcn_mbcnt_hi((unsigned)(sm >> 32), __builtin_amdgcn_mbcnt_lo((unsigned)sm, 0u));
        if (selc && pos < 256) op[pos] = (unsigned short)ce;
      } else {
#define KEYOF(j) (((lane + 64 * (j)) <= t) ? (__float_as_uint(v[j]) ^ ((__float_as_uint(v[j]) >> 31) ? 0xFFFFFFFFu : 0x80000000u)) : 0u)
        unsigned prefix = 0u;
        for (int bit = 31; bit >= 0; --bit) {
          const unsigned cnd = prefix | (1u << bit); int cnt = 0;
#pragma unroll
          for (int j = 0; j < 32; ++j) cnt += __popcll(__ballot(KEYOF(j) >= cnd));
          if (cnt >= 256) prefix = cnd;
        }
        int cgt = 0;
#pragma unroll
        for (int j = 0; j < 32; ++j) cgt += __popcll(__ballot(KEYOF(j) > prefix));
        const int need2 = 256 - cgt; int base2 = 0, tb = 0;
#pragma unroll
        for (int j = 0; j < 32; ++j) {
          const unsigned uj = KEYOF(j); const bool gt = uj > prefix, eq = (uj == prefix);
          const unsigned long long eqm = __ballot(eq);
          const int trank = tb + (int)__builtin_amdgcn_mbcnt_hi((unsigned)(eqm >> 32), __builtin_amdgcn_mbcnt_lo((unsigned)eqm, 0u));
          const bool sel = gt || (eq && trank < need2);
          const unsigned long long sm = __ballot(sel);
          const int pos = base2 + (int)__builtin_amdgcn_mbcnt_hi((unsigned)(sm >> 32), __builtin_amdgcn_mbcnt_lo((unsigned)sm, 0u));
          if (sel && pos < 256) op[pos] = (unsigned short)(lane + 64 * j);
          base2 += __popcll(sm); tb += __popcll(eqm);
        }
#undef KEYOF
      }
    }
    __syncthreads();
  }
}

__device__ __forceinline__ void pair_sync(LAS unsigned* cnt, unsigned target, int lane) {
  asm volatile("" ::: "memory");
  if (lane == 0) __hip_atomic_fetch_add(cnt, 1u, __ATOMIC_RELAXED, __HIP_MEMORY_SCOPE_WORKGROUP);
  while (__hip_atomic_load(cnt, __ATOMIC_RELAXED, __HIP_MEMORY_SCOPE_WORKGROUP) < target) __builtin_amdgcn_s_sleep(1);
  asm volatile("" ::: "memory");
}
constexpr int CROW = 544;
constexpr int CTOK = 32 * CROW;
constexpr int CBUF = 4 * CTOK;
__device__ __forceinline__ void p4_attn(const Params& p, unsigned char* lds, int bid, int nb, bool dry) {
  LAS unsigned char* cbuf = (LAS unsigned char*)lds;
  LAS float* biasd = (LAS float*)((LAS unsigned char*)lds + 2 * CBUF);
  LAS unsigned short* idxs = (LAS unsigned short*)((LAS unsigned char*)lds + 2 * CBUF + 129 * 32 * 4);
  const bf16_t* ckvn = (const bf16_t*)(p.ws + OFF_CKVN); const unsigned short* idxg = (const unsigned short*)(p.ws + OFF_IDX);
  unsigned char* QL = p.ws + OFF_QL0;
  int tid = threadIdx.x; asm volatile("" : "+v"(tid));
  const int lane = tid & 63, wid = __builtin_amdgcn_readfirstlane(tid >> 6), g = lane >> 4, r16 = lane & 15;
  for (int i = tid; i < 129 * 32; i += 512) {
    const int d = i >> 5, hd = i & 31; int bucket = d;
    if (d >= 16) { bucket = 16 + (d >= 19) + (d >= 21) + (d >= 24) + (d >= 27) + (d >= 31) + (d >= 35) + (d >= 40) + (d >= 46) + (d >= 52) + (d >= 59) + (d >= 67) + (d >= 77) + (d >= 87) + (d >= 99) + (d >= 113); }
    biasd[i] = ((const float*)(p.ws + OFF_SMALL))[SM_RELB + bucket * 32 + hd] * LOG2E;
  }
  LAS unsigned* pcnt = (LAS unsigned*)((LAS unsigned char*)lds + 2 * CBUF + 129 * 32 * 4 + 2048) + (wid >> 1);
  if (tid < 4) ((LAS unsigned*)((LAS unsigned char*)lds + 2 * CBUF + 129 * 32 * 4 + 2048))[tid] = 0u;
  __syncthreads();
  unsigned epoch = 0u;
  const int tok = wid >> 1, hw = wid & 1, head = hw * 16 + r16;
  const float SC = 0.08838834764831845f * LOG2E;
  const int qoff = 16 * (g ^ (r16 >> 3));
  const int q4 = r16 >> 2, pp = r16 & 3;
  const int troff = (4 * g + q4) * CROW + 16 * ((pp >> 1) ^ (g >> 1)) + 8 * (pp & 1);
  const int wrow = 16 * hw + 8 * (lane >> 5), wch = lane & 31;
  for (int round = 0; round * nb < T / 4; ++round) {
    const int item = round * nb + (bid + round * 37) % nb;
    const int tg0 = item * 4, b = tg0 >> 11, t0 = tg0 & 2047, t = t0 + tok, tg = tg0 + tok;
    const int nk = min(t + 1, 256), nkmax = min(t0 + 4, 256), nch = (nkmax + 31) >> 5;
    ((LAS unsigned*)idxs)[tid] = ((const unsigned*)(idxg + (size_t)tg0 * 256))[tid];
    unsigned char* qrow = QL + (size_t)tg * 8192 + head * 256;
    bf16x8 qB[8];
#pragma unroll
    for (int s = 0; s < 8; ++s) { const u32x2 qw = *(const u32x2*)(qrow + 32 * s + 8 * g);
      typedef float f32x2v __attribute__((ext_vector_type(2)));
      const f32x2v a0 = __builtin_amdgcn_cvt_pk_f32_fp8(qw[0], false), a1 = __builtin_amdgcn_cvt_pk_f32_fp8(qw[0], true), a2 = __builtin_amdgcn_cvt_pk_f32_fp8(qw[1], false), a3 = __builtin_amdgcn_cvt_pk_f32_fp8(qw[1], true);
      u32x4 pw; pw[0] = cvt_pk_bf16(a0[0], a0[1]); pw[1] = cvt_pk_bf16(a1[0], a1[1]); pw[2] = cvt_pk_bf16(a2[0], a2[1]); pw[3] = cvt_pk_bf16(a3[0], a3[1]);
      union { u32x4 u; bf16x8 v; } cv; cv.u = pw; qB[s] = cv.v; }
    epoch += 2u; pair_sync(pcnt, epoch, lane);
    u32x4 stg[8];
    const bf16_t* cbase = ckvn + (size_t)b * L * 256 + wch * 8;
#define P4_LOAD(ch) do { const u32x4 kk_ = *(const LAS u32x4*)(idxs + tok * 256 + (ch) * 32 + wrow); \
      _Pragma("unroll") for (int i = 0; i < 8; ++i) { \
      const int key = (int)((kk_[i >> 1] >> (16 * (i & 1))) & 0xffffu); stg[i] = *(const u32x4*)(cbase + (size_t)key * 256); } } while (0)
#define P4_WRITE(bufp) do { _Pragma("unroll") for (int i = 0; i < 8; ++i) \
      *(LAS u32x4*)((bufp) + (wrow + i) * CROW + 16 * (wch ^ (lane >> 5))) = stg[i]; } while (0)
    P4_LOAD(0);
    P4_WRITE(cbuf + tok * CTOK);
    if (nch > 1) P4_LOAD(1);
    float m_run = -1e30f, l_run = 0.f;
    f32x4 o[16];
#pragma unroll
    for (int ct = 0; ct < 16; ++ct) o[ct] = (f32x4){0.f, 0.f, 0.f, 0.f};
    epoch += 2u; pair_sync(pcnt, epoch, lane);
    for (int ch = 0; ch < nch; ++ch) {
      LAS unsigned char* cb = cbuf + (ch & 1) * CBUF + tok * CTOK;
      if (ch + 1 < nch) { P4_WRITE(cbuf + ((ch + 1) & 1) * CBUF + tok * CTOK); if (ch + 2 < nch) P4_LOAD(ch + 2); }
      f32x4 s0 = (f32x4){0.f, 0.f, 0.f, 0.f}, s1 = (f32x4){0.f, 0.f, 0.f, 0.f};
#pragma unroll
      for (int s = 0; s < 8; ++s) {
        const bf16x8 a0 = *(const LAS bf16x8*)(cb + r16 * CROW + s * 64 + qoff);
        const bf16x8 a1 = *(const LAS bf16x8*)(cb + (16 + r16) * CROW + s * 64 + qoff);
        s0 = __builtin_amdgcn_mfma_f32_16x16x32_bf16(a0, qB[s], s0, 0, 0, 0);
        s1 = __builtin_amdgcn_mfma_f32_16x16x32_bf16(a1, qB[s], s1, 0, 0, 0);
      }
      const int slotb = ch * 32 + 4 * g;
      const u32x2 k0 = *(const LAS u32x2*)(idxs + tok * 256 + slotb), k1 = *(const LAS u32x2*)(idxs + tok * 256 + slotb + 16);
      float lg0[4], lg1[4]; float mx = -1e30f;
      const bool full = (ch * 32 + 32 <= nk);
      int dd0[4], dd1[4]; int dmin = 1 << 20;
#pragma unroll
      for (int i = 0; i < 4; ++i) {
        const int key0 = (int)((k0[i >> 1] >> (16 * (i & 1))) & 0xffffu), key1 = (int)((k1[i >> 1] >> (16 * (i & 1))) & 0xffffu);
        dd0[i] = t - key0; dd1[i] = t - key1; dmin = min(dmin, min(dd0[i], dd1[i]));
      }
      if (__ballot(dmin < 128) == 0ull) {
        const float bfar = biasd[128 * 32 + head];
#pragma unroll
        for (int i = 0; i < 4; ++i) { lg0[i] = s0[i] * SC + bfar; lg1[i] = s1[i] * SC + bfar; }
      } else {
#pragma unroll
        for (int i = 0; i < 4; ++i) {
          const int d0 = min(max(dd0[i], 0), 128), d1 = min(max(dd1[i], 0), 128);
          lg0[i] = s0[i] * SC + biasd[d0 * 32 + head];
          lg1[i] = s1[i] * SC + biasd[d1 * 32 + head];
        }
      }
#pragma unroll
      for (int i = 0; i < 4; ++i) {
        if (!full) {
          lg0[i] = (slotb + i < nk) ? lg0[i] : -1e30f;
          lg1[i] = (slotb + 16 + i < nk) ? lg1[i] : -1e30f;
        }
        mx = vmax(mx, vmax(lg0[i], lg1[i]));
      }
      mx = pmax32(pmax16(mx));
      float alpha = 1.f;
      if (__ballot(mx > m_run + 8.f) != 0ull) {
        const float m_new = vmax(m_run, mx); alpha = __builtin_amdgcn_exp2f(m_run - m_new); m_run = m_new;
#pragma unroll
        for (int ct = 0; ct < 16; ++ct) o[ct] *= alpha;
      }
      float ps = 0.f; f32x4 p0, p1;
#pragma unroll
      for (int i = 0; i < 4; ++i) { p0[i] = __builtin_amdgcn_exp2f(lg0[i] - m_run); p1[i] = __builtin_amdgcn_exp2f(lg1[i] - m_run); ps += p0[i] + p1[i]; }
      l_run = l_run * alpha + ps;
      const u32x4 pw = pack8(p0, p1);
      bf16x8 pb; { union { u32x4 u; bf16x8 v; } cv; cv.u = pw; pb = cv.v; }
      LAS unsigned char* trb = cb + troff;
#pragma unroll
      for (int ct = 0; ct < 16; ++ct) {
        const s16x4 ta = __builtin_amdgcn_ds_read_tr16_b64_v4i16((LAS s16x4*)(trb + 32 * ct));
        const s16x4 tb = __builtin_amdgcn_ds_read_tr16_b64_v4i16((LAS s16x4*)(trb + 16 * CROW + 32 * ct));
        const bf16x8 a = {ta[0], ta[1], ta[2], ta[3], tb[0], tb[1], tb[2], tb[3]};
        o[ct] = __builtin_amdgcn_mfma_f32_16x16x32_bf16(a, pb, o[ct], 0, 0, 0);
      }
      epoch += 2u; pair_sync(pcnt, epoch, lane);
    }
    const float l = psum32(psum16(l_run));
    const float inv = 16.f / l;
    unsigned char* orow = qrow + 4 * g;
#pragma unroll
    for (int ct = 0; ct < 16; ++ct) {
      unsigned w = __builtin_amdgcn_cvt_pk_fp8_f32(o[ct][0] * inv, o[ct][1] * inv, 0, false); w = __builtin_amdgcn_cvt_pk_fp8_f32(o[ct][2] * inv, o[ct][3] * inv, w, true);
      if (!dry) *(unsigned*)(orow + 16 * ct) = w;
    }
#undef P4_LOAD
#undef P4_WRITE
  }
}

__device__ __forceinline__ void p8_pool(const Params& p, int bid, int nb) {
  const bf16_t* U = (const bf16_t*)(p.ws + OFF_RQ); const bf16_t* Z = (const bf16_t*)(p.ws + OFF_RZ); bf16_t* Y = (bf16_t*)p.out;
  int tid = threadIdx.x; asm volatile("" : "+v"(tid));
  const int n0 = tid * 8, w = 2 << (tid >> 7);
  float bg[8], scl[8];
#pragma unroll
  for (int j = 0; j < 8; ++j) { bg[j] = ((const float*)(p.ws + OFF_SMALL))[SM_BGRP + n0 + j]; scl[j] = ((const float*)(p.ws + OFF_SMALL))[SM_SCALE + n0 + j]; }
  for (int item = bid; item < T / 32; item += nb) {
    const int tg0 = item * 32, t0 = tg0 & 2047;
    const bf16_t* ub = U + (size_t)(tg0 - t0) * 4096 + n0;
    float sum[8];
#pragma unroll
    for (int j = 0; j < 8; ++j) sum[j] = 0.f;
    { u32x4 pv[15];
#pragma unroll
      for (int k = 1; k < 16; ++k) { const int s = t0 - k; pv[k - 1] = (k < w && s >= 0) ? *(const u32x4*)(ub + (size_t)s * 4096) : (u32x4){0u, 0u, 0u, 0u}; }
#pragma unroll
      for (int k = 0; k < 15; ++k)
#pragma unroll
        for (int j = 0; j < 4; ++j) { sum[2 * j] += bflo(pv[k][j]); sum[2 * j + 1] += bfhi(pv[k][j]); } }
    for (int tb = 0; tb < 32; tb += 4) {
      u32x4 cv[4], zv[4], ov[4];
#pragma unroll
      for (int k = 0; k < 4; ++k) {
        const int t = t0 + tb + k;
        cv[k] = *(const u32x4*)(ub + (size_t)t * 4096);
        zv[k] = *(const u32x4*)(Z + (size_t)(tg0 + tb + k) * 4096 + n0);
        ov[k] = (t - w + 1 >= 0) ? *(const u32x4*)(ub + (size_t)(t - w + 1) * 4096) : (u32x4){0u, 0u, 0u, 0u};
      }
#pragma unroll
      for (int k = 0; k < 4; ++k) {
        const int t = t0 + tb + k;
        float cur[8], zf[8], y[8];
#pragma unroll
        for (int j = 0; j < 4; ++j) { cur[2 * j] = bflo(cv[k][j]); cur[2 * j + 1] = bfhi(cv[k][j]); zf[2 * j] = bflo(zv[k][j]); zf[2 * j + 1] = bfhi(zv[k][j]); }
        const float icnt = __builtin_amdgcn_rcpf((float)min(w, t + 1));
#pragma unroll
        for (int j = 0; j < 8; ++j) { sum[j] += cur[j]; y[j] = ((sum[j] * icnt - cur[j]) + bg[j]) * scl[j] * silu_fast(zf[j]); }
        u32x4 o; o[0] = cvt_pk_bf16(y[0], y[1]); o[1] = cvt_pk_bf16(y[2], y[3]); o[2] = cvt_pk_bf16(y[4], y[5]); o[3] = cvt_pk_bf16(y[6], y[7]);
        *(u32x4*)(Y + (size_t)(tg0 + tb + k) * 4096 + n0) = o;
#pragma unroll
        for (int j = 0; j < 4; ++j) { sum[2 * j] -= bflo(ov[k][j]); sum[2 * j + 1] -= bfhi(ov[k][j]); }
        asm volatile("" ::: "memory");
      }
    }
  }
}

__device__ __forceinline__ void p10_final(const Params& p, int bid, int nb) {
  int tid = threadIdx.x; asm volatile("" : "+v"(tid));
  const int lane = tid & 63, wid = tid >> 6;
  const float* ss2 = (const float*)(p.ws + OFF_SS) + 2 * T;
  const bf16_t* h2 = (const bf16_t*)(p.ws + OFF_RQ);
  f32x4 g[8];
#pragma unroll
  for (int j = 0; j < 8; ++j) g[j] = *(const f32x4*)((const float*)(p.ws + OFF_SMALL) + SM_FINAL + (lane + 64 * j) * 4);
  for (int row = bid * 8 + wid; row < T; row += nb * 8) {
    const float r = rsqrtf(ss2[row] * (1.f / 2048.f) + EPS);
    f32x4* ptr = (f32x4*)(p.out + (size_t)row * D);
    u32x2 hv[8];
#pragma unroll
    for (int j = 0; j < 8; ++j) hv[j] = *(const u32x2*)(h2 + (size_t)row * D + (lane + 64 * j) * 4);
#pragma unroll
    for (int j = 0; j < 8; ++j) { const f32x4 v = {bflo(hv[j][0]), bfhi(hv[j][0]), bflo(hv[j][1]), bfhi(hv[j][1])}; ptr[lane + 64 * j] = v * r * g[j]; }
  }
}

__device__ __forceinline__ void grid_bar(unsigned* ctr, unsigned target) {
  __syncthreads();
  if (threadIdx.x == 0) {
    __builtin_amdgcn_fence(__ATOMIC_RELEASE, "agent");
    asm volatile("s_waitcnt vmcnt(0)" ::: "memory");
    __hip_atomic_fetch_add(ctr, 1u, __ATOMIC_RELAXED, __HIP_MEMORY_SCOPE_AGENT);
    while (__hip_atomic_load(ctr, __ATOMIC_RELAXED, __HIP_MEMORY_SCOPE_AGENT) < target) __builtin_amdgcn_s_sleep(2);
    __builtin_amdgcn_fence(__ATOMIC_ACQUIRE, "agent");
    asm volatile("s_waitcnt vmcnt(0)" ::: "memory");
  }
  __syncthreads();
}

__global__ void __launch_bounds__(512, 2) fwd_mega(Params p) {
  extern __shared__ __attribute__((aligned(16))) unsigned char lds[];
  cg::grid_group grid = cg::this_grid();
  const int bid = blockIdx.x, nb = gridDim.x;
  unsigned char* ws = p.ws;
  LAS unsigned char* gl = (LAS unsigned char*)lds;
  float* ss = (float*)(ws + OFF_SS);
  unsigned* bar = (unsigned*)(ws + OFF_BAR);

#define REPS(k)
#define DRY false
  if (bid == 0 && threadIdx.x == 0) __hip_atomic_store(bar, 0u, __ATOMIC_RELAXED, __HIP_MEMORY_SCOPE_AGENT);
  REPS(0) { p0_prep(p, lds, bid, nb); __syncthreads(); }
  grid.sync();

  REPS(1) {
    g8::Sched S; S.init(16, 8, nb, (bid + (nb >> 1)) % nb); S.A0 = (const char*)(ws + OFF_WG); S.sAm = (size_t)256 * 1024 * 2; S.B0 = (const char*)(ws + OFF_WU); S.sBn = (size_t)256 * 1024 * 2; S.sBg = (size_t)2048 * 1024 * 2; S.gshift = 2;
    g8::EpiBf16 E{(bf16_t*)(ws + OFF_WB), nullptr, 1 << 30, LDWB, nullptr};
    g8::gemm_phase(gl, 1024, 1024, 1024, S, E);
  }
  REPS(2) {
    { g8::Sched S; S.init(128, 32, nb, bid); S.A0 = (const char*)(ws + OFF_XQ); S.sAm = (size_t)256 * 2048; S.B0 = (const char*)(ws + OFF_WA); S.sBn = (size_t)256 * 2048;
      g8::EpiProjA E{ss, (bf16_t*)(ws + OFF_RQ), (bf16_t*)(ws + OFF_RZ), (float*)(ws + OFF_CKVR), (bf16_t*)(ws + OFF_QIDX), (bf16_t*)(ws + OFF_KIDX), (float*)(ws + OFF_WIDX), (const float*)(ws + OFF_SMALL) + SM_KIDXN, 0, 1.f / 64.f};
      g8::gemm_phase<g8::EpiProjA, true>(gl, 1024, 1024, 1024, S, E); }
    { g8::Sched S; S.init(128, 6, nb, bid); S.A0 = (const char*)(ws + OFF_QL0); S.sAm = (size_t)256 * 2048 * 2; S.B0 = (const char*)(ws + OFF_WAI); S.sBn = (size_t)256 * 2048 * 2;
      g8::EpiProjA E{ss, (bf16_t*)(ws + OFF_RQ), (bf16_t*)(ws + OFF_RZ), (float*)(ws + OFF_CKVR), (bf16_t*)(ws + OFF_QIDX), (bf16_t*)(ws + OFF_KIDX), (float*)(ws + OFF_WIDX), (const float*)(ws + OFF_SMALL) + SM_KIDXN, 32, 1.f};
      g8::gemm_phase(gl, 2048, 2048, 2048, S, E); }
  }
  grid_bar(bar, (unsigned)(1 * nb));

  REPS(3) { p3_indexer(p, lds, bid, nb, 1, 1); __syncthreads(); }
  REPS(11) { p3_ckvnorm(p, bid, nb); }
  __syncthreads();
  REPS(12) {
    g8::Sched S; S.init(128, 32, nb, bid); S.A0 = (const char*)(ws + OFF_RQ); S.sAm = (size_t)256 * 4096; S.sAn = 256; S.anshift = 1; S.B0 = (const char*)(ws + OFF_WUK); S.sBn = (size_t)256 * 256;
    g8::EpiQlat E{ws + OFF_QL0, 1.f / 16.f};
    g8::gemm_phase<g8::EpiQlat, true, 2>(gl, 128, 2048, 128, S, E);
  }
  grid_bar(bar, (unsigned)(2 * nb));

  REPS(4) { p4_attn(p, lds, bid, nb, DRY); __syncthreads(); }
  grid_bar(bar, (unsigned)(3 * nb));

  REPS(5) {
    g8::Sched S; S.init(128, 16, nb, bid); S.A0 = (const char*)(ws + OFF_QL0); S.sAm = (size_t)256 * 8192; S.sAn = 512; S.B0 = (const char*)(ws + OFF_WUV); S.sBn = (size_t)256 * 512;
    g8::EpiGate E{ws + OFF_RQ, ws + OFF_RZ, 16.f / 256.f};
    g8::gemm_phase<g8::EpiGate, true, 1>(gl, 256, 4096, 256, S, E);
  }
  grid_bar(bar, (unsigned)(4 * nb));

  REPS(6) {
    g8::Sched S; S.init(128, 8, nb, bid); S.A0 = (const char*)(ws + OFF_RQ); S.sAm = (size_t)256 * 4096; S.B0 = (const char*)(ws + OFF_WOUTA); S.sBn = (size_t)256 * 4096;
    g8::EpiRes E{p.x, nullptr, 0, nullptr, (bf16_t*)(ws + OFF_QL0), LDH, ss + T, 1.f / 1024.f};
    g8::gemm_phase<g8::EpiRes, true>(gl, 2048, 2048, 2048, S, E);
  }
  grid_bar(bar, (unsigned)(5 * nb));

  REPS(7) {
    g8::Sched S; S.init(128, 32, nb, bid); S.A0 = (const char*)(ws + OFF_QL0); S.sAm = (size_t)256 * LDH * 2; S.B0 = (const char*)(ws + OFF_WB); S.sBn = (size_t)256 * LDWB * 2;
    g8::EpiBf16 E{(bf16_t*)(ws + OFF_RQ), (bf16_t*)(ws + OFF_RZ), 16, 4096, ss + T};
    g8::gemm_phase(gl, 2048, LDH, LDWB, S, E);
  }
  grid_bar(bar, (unsigned)(6 * nb));

  REPS(8) { p8_pool(p, bid, nb); }
  grid_bar(bar, (unsigned)(7 * nb));

  REPS(9) {
    g8::Sched S; S.init(128, 8, nb, bid); S.A0 = (const char*)p.out; S.sAm = (size_t)256 * 4096 * 2; S.B0 = (const char*)(ws + OFF_WOUTB); S.sBn = (size_t)256 * 4096 * 2;
    g8::EpiRes E{nullptr, (const bf16_t*)(ws + OFF_QL0), LDH, nullptr, (bf16_t*)(ws + OFF_RQ), 2048, ss + 2 * T, 1.f};
    g8::gemm_phase(gl, 4096, 4096, 4096, S, E);
  }
  grid_bar(bar, (unsigned)(8 * nb));

  p10_final(p, bid, nb);
}

extern "C" void kernel_launch(void* const* d_in, const int* in_sizes, int n_in,
                              void* d_out, int out_size, void* d_ws, size_t ws_size,
                              hipStream_t stream) {
  static int grid_blocks = 0;
  if (!grid_blocks) {
    int dev = 0, cus = 0, per_cu = 0;
    (void)hipGetDevice(&dev);
    (void)hipDeviceGetAttribute(&cus, hipDeviceAttributeMultiprocessorCount, dev);
    (void)hipFuncSetAttribute((const void*)fwd_mega, hipFuncAttributeMaxDynamicSharedMemorySize, LDS_BYTES);
    (void)hipOccupancyMaxActiveBlocksPerMultiprocessor(&per_cu, (const void*)fwd_mega, 512, LDS_BYTES);
    if (per_cu < 1) per_cu = 1;
    grid_blocks = cus * per_cu;
    if (ws_size < WS_END) fprintf(stderr, "kernel_launch: workspace too small: %zu < %zu\n", ws_size, (size_t)WS_END);
  }
  Params p{};
  p.x = (const float*)d_in[0]; p.norm_a = (const float*)d_in[1]; p.w_in_a = (const float*)d_in[2]; p.kv_norm = (const float*)d_in[3];
  p.kidx_norm = (const float*)d_in[4]; p.w_uk = (const float*)d_in[5]; p.w_uv = (const float*)d_in[6]; p.w_out_a = (const float*)d_in[7];
  p.norm_b = (const float*)d_in[8]; p.w_in_b = (const float*)d_in[9]; p.w_grp = (const float*)d_in[10]; p.b_grp = (const float*)d_in[11];
  p.scale_b = (const float*)d_in[12]; p.w_out_b = (const float*)d_in[13]; p.rel_bias = (const float*)d_in[14]; p.final_norm = (const float*)d_in[15];
  p.out = (float*)d_out; p.ws = (unsigned char*)d_ws; p.probe = PROBE_PHASE; p.pad = 0;
  void* args[] = {&p};
  hipError_t e = hipLaunchCooperativeKernel((void*)fwd_mega, dim3(grid_blocks), dim3(512), args, LDS_BYTES, stream);
  if (e != hipSuccess) fprintf(stderr, "cooperative launch failed: %s (grid %d)\n", hipGetErrorString(e), grid_blocks);
}
```

```cpp
#include <hip/hip_runtime.h>
#include <hip/hip_cooperative_groups.h>
#include <cstdio>
#include <cstdint>
namespace cg = cooperative_groups;

#define LAS __attribute__((address_space(3)))
typedef unsigned short bf16_t;
typedef short bf16x8 __attribute__((ext_vector_type(8)));
typedef short s16x4 __attribute__((ext_vector_type(4)));
typedef float f32x4 __attribute__((ext_vector_type(4)));
typedef float f32x16 __attribute__((ext_vector_type(16)));
typedef unsigned u32x4 __attribute__((ext_vector_type(4)));
typedef unsigned u32x2 __attribute__((ext_vector_type(2)));

constexpr int T = 32768, L = 2048, D = 2048, DI = 4096;
constexpr float EPS = 1e-6f;
constexpr float LOG2E = 1.4426950408889634f;
constexpr int LDS_BYTES = 156 * 1024;
#ifndef PROBE_PHASE
#define PROBE_PHASE -1
#endif

constexpr size_t OFF_RQ = 0;
constexpr size_t OFF_RZ = 268435456;
constexpr size_t OFF_QL0 = 536870912;
constexpr size_t OFF_XQ = OFF_QL0 + 134217728;
constexpr size_t OFF_WOUTA = 805306368;
constexpr size_t OFF_WB = OFF_WOUTA + 16777216;
constexpr int LDH = 2112, LDWB = 2112;
constexpr size_t OFF_WU = OFF_WB + (size_t)8192 * LDWB * 2;
constexpr size_t OFF_WG = OFF_WU + 16777216;
constexpr size_t OFF_WOUTB = OFF_WG + 8388608;
constexpr size_t OFF_WUK = OFF_WOUTB + 16777216;
constexpr size_t OFF_WUV = OFF_WUK + 2097152;
constexpr size_t OFF_WA = OFF_WUV + 4194304;
constexpr size_t OFF_WAI = OFF_WA + (size_t)8192 * 2048;
constexpr size_t OFF_IDX = OFF_WA;
constexpr size_t OFF_CKVN = OFF_WA + 16777216;
constexpr size_t OFF_CKVR = OFF_WA + 39845888;
constexpr size_t OFF_QIDX = OFF_CKVR + 33554432;
constexpr size_t OFF_KIDX = OFF_QIDX + 67108864;
constexpr size_t OFF_WIDX = OFF_KIDX + 4194304;
constexpr size_t OFF_SS = OFF_WIDX + 2097152;
constexpr size_t OFF_BAR = OFF_SS + 3 * 131072;
constexpr size_t OFF_SMALL = OFF_BAR + 256;
constexpr int SM_KIDXN = 0, SM_KVN = 64, SM_RELB = 320, SM_BGRP = 1344, SM_SCALE = 5440, SM_FINAL = 9536, SM_TOTAL = 11584;
constexpr size_t WS_END = OFF_SMALL + (size_t)SM_TOTAL * 4;

struct Params {
  const float *x, *norm_a, *w_in_a, *kv_norm, *kidx_norm, *w_uk, *w_uv, *w_out_a, *norm_b, *w_in_b, *w_grp, *b_grp, *scale_b, *w_out_b, *rel_bias, *final_norm;
  float* out; unsigned char* ws; int probe; int pad;
};

__device__ __forceinline__ unsigned cvt_pk_bf16(float lo, float hi) { unsigned r; asm("v_cvt_pk_bf16_f32 %0, %1, %2" : "=v"(r) : "v"(lo), "v"(hi)); return r; }
__device__ __forceinline__ float bf2f(unsigned short b) { return __uint_as_float(((unsigned)b) << 16); }
__device__ __forceinline__ float bflo(unsigned w) { return __uint_as_float(w << 16); }
__device__ __forceinline__ float bfhi(unsigned w) { return __uint_as_float(w & 0xffff0000u); }
__device__ __forceinline__ u32x4 pack8(f32x4 a, f32x4 b) { u32x4 w; w[0] = cvt_pk_bf16(a[0], a[1]); w[1] = cvt_pk_bf16(a[2], a[3]); w[2] = cvt_pk_bf16(b[0], b[1]); w[3] = cvt_pk_bf16(b[2], b[3]); return w; }
__device__ __forceinline__ float sx(float v, int mask, int lane) { return __int_as_float(__builtin_amdgcn_ds_bpermute((lane ^ mask) << 2, __float_as_int(v))); }
typedef unsigned u32x2s __attribute__((ext_vector_type(2)));
__device__ __forceinline__ float pmax16(float x) { const u32x2s r = __builtin_amdgcn_permlane16_swap(__float_as_uint(x), __float_as_uint(x), false, false); return __builtin_amdgcn_fmed3f(__uint_as_float(r[0]), __uint_as_float(r[1]), __builtin_inff()); }
__device__ __forceinline__ float pmax32(float x) { const u32x2s r = __builtin_amdgcn_permlane32_swap(__float_as_uint(x), __float_as_uint(x), false, false); return __builtin_amdgcn_fmed3f(__uint_as_float(r[0]), __uint_as_float(r[1]), __builtin_inff()); }
__device__ __forceinline__ float psum16(float x) { const u32x2s r = __builtin_amdgcn_permlane16_swap(__float_as_uint(x), __float_as_uint(x), false, false); return __uint_as_float(r[0]) + __uint_as_float(r[1]); }
__device__ __forceinline__ float psum32(float x) { const u32x2s r = __builtin_amdgcn_permlane32_swap(__float_as_uint(x), __float_as_uint(x), false, false); return __uint_as_float(r[0]) + __uint_as_float(r[1]); }
template <int CTRL> __device__ __forceinline__ float dppf(float x) { return __int_as_float(__builtin_amdgcn_update_dpp(0, __float_as_int(x), CTRL, 0xf, 0xf, false)); }
__device__ __forceinline__ float vmin(float a, float b) { return __builtin_amdgcn_fmed3f(a, b, -__builtin_inff()); }
__device__ __forceinline__ float pmin16(float x) { const u32x2s r = __builtin_amdgcn_permlane16_swap(__float_as_uint(x), __float_as_uint(x), false, false); return vmin(__uint_as_float(r[0]), __uint_as_float(r[1])); }
__device__ __forceinline__ float pmin32(float x) { const u32x2s r = __builtin_amdgcn_permlane32_swap(__float_as_uint(x), __float_as_uint(x), false, false); return vmin(__uint_as_float(r[0]), __uint_as_float(r[1])); }
__device__ __forceinline__ float wave_sum(float s, int) { s += dppf<0x128>(s); s += dppf<0x124>(s); s += dppf<0x122>(s); s += dppf<0x121>(s); return psum32(psum16(s)); }
__device__ __forceinline__ float wave_max(float s) { s = __builtin_amdgcn_fmed3f(s, dppf<0x128>(s), __builtin_inff()); s = __builtin_amdgcn_fmed3f(s, dppf<0x124>(s), __builtin_inff()); s = __builtin_amdgcn_fmed3f(s, dppf<0x122>(s), __builtin_inff()); s = __builtin_amdgcn_fmed3f(s, dppf<0x121>(s), __builtin_inff()); return pmax32(pmax16(s)); }
__device__ __forceinline__ float wave_min(float s) { s = vmin(s, dppf<0x128>(s)); s = vmin(s, dppf<0x124>(s)); s = vmin(s, dppf<0x122>(s)); s = vmin(s, dppf<0x121>(s)); return pmin32(pmin16(s)); }
__device__ __forceinline__ float vmax(float a, float b) { return __builtin_amdgcn_fmed3f(a, b, __builtin_inff()); }
__device__ __forceinline__ float relu_i(float x) { return __int_as_float(max(__float_as_int(x), 0)); }
__device__ __forceinline__ float silu(float z) { return z / (1.f + __expf(-z)); }
__device__ __forceinline__ float silu_fast(float z) { return z * __builtin_amdgcn_rcpf(1.f + __builtin_amdgcn_exp2f(-1.4426950408889634f * z)); }

namespace g8 {
constexpr int BM = 256, BK = 64, HALF = 128, HTB = HALF * BK * 2, STAGE_BYTES = 8 * HTB, NXCD = 8, WGM = 2;
__device__ __forceinline__ int lds_byte(int r, int c) { const int st = (r >> 4) * 2 + (c >> 5), rr = r & 15, cc = c & 31, ob = rr * 64 + cc * 2; return st * 1024 + (ob ^ (((ob >> 9) & 1) << 5)); }
__device__ __forceinline__ void stage_rc(int b, int& R, int& C) { const int st = b / 1024, sb = b % 1024, swz = sb ^ (((sb >> 9) & 1) << 5); R = (st >> 1) * 16 + swz / 64; C = (st & 1) * 32 + (swz % 64) / 2; }
__device__ __forceinline__ int perm32(int rho) { const int n = rho >> 4, i = rho & 15; return 8 * (i >> 2) + 4 * n + (i & 3); }

struct GUnit { const char* A; const char* B; int pm, pn; };

struct Sched {
  int nM, nN, nwg, G, c;
  const char* A0; const char* A1; int pmSplit; size_t sAm, sAn;
  const char* B0; size_t sBn, sBg; int gshift; int anshift;
  __device__ __forceinline__ void init(int nM_, int nN_, int G_, int c_) { nM = nM_; nN = nN_; nwg = nM * nN; G = G_; c = c_; A1 = nullptr; pmSplit = 1 << 30; sAn = 0; sBg = 0; gshift = 0; anshift = 0; }
  __device__ __forceinline__ bool next(int i, GUnit& u) const {
    const int Lx = i * G + c; if (Lx >= nwg) return false;
    int wgid = Lx; { const int q = nwg / NXCD, r = nwg % NXCD, xcd = wgid % NXCD, off = wgid / NXCD; wgid = (xcd < r ? xcd * (q + 1) : r * (q + 1) + (xcd - r) * q) + off; }
    const int nig = WGM * nN, gid = wgid / nig, fm = gid * WGM, gsz = (nM - fm) < WGM ? (nM - fm) : WGM;
    u.pm = fm + ((wgid % nig) % gsz); u.pn = (wgid % nig) / gsz;
    u.A = (u.pm < pmSplit ? A0 + (size_t)u.pm * sAm : A1 + (size_t)(u.pm - pmSplit) * sAm) + (size_t)(u.pn >> anshift) * sAn;
    u.B = B0 + (size_t)u.pn * sBn + (size_t)(u.pm >> gshift) * sBg;
    return true;
  }
};

typedef int v8i __attribute__((ext_vector_type(8)));
__device__ __forceinline__ v8i cat8(bf16x8 a, bf16x8 b) { union { bf16x8 h[2]; v8i v; } u; u.h[0] = a; u.h[1] = b; return u.v; }
template <class Epi, bool FP8 = false, int BD = 0>
__device__ __forceinline__ void gemm_phase(LAS unsigned char* lds, const int K, const int lda, const int ldb, const Sched& S, const Epi& E) {
  int tid = threadIdx.x; asm volatile("" : "+v"(tid));
  const int wid = __builtin_amdgcn_readfirstlane(tid >> 6), lane = tid & 63, wr = wid >> 2, wc = wid & 3, fr = lane & 15, fq = lane >> 4;
  const int nt = K / BK;
  unsigned voffA, voffB;
  { int R, C; stage_rc(tid * 16, R, C); const int Rb = (R & ~31) + perm32(R & 31); voffA = (unsigned)(R * lda + C) * 2u; voffB = (unsigned)(Rb * ldb + C) * 2u; }
  const size_t p2A = (size_t)64 * lda * 2, p2B = (size_t)64 * ldb * 2;
  const size_t kstep = (size_t)(BK * 2);
  const size_t hstepA = (size_t)HALF * lda * 2, hstepB = (size_t)HALF * ldb * 2;
  const unsigned ldsw = (unsigned)wid * 1024u;
  const int aoff = lds_byte(wr * 64 + fr, fq * 8), boff = lds_byte(wc * 32 + fr, fq * 8);
#define G8_SA(b, h) (((b) * 2 + (h)) * HTB)
#define G8_SB(b, h) ((4 + (b) * 2 + (h)) * HTB)
#define G8_STAGE(bufoff, gbase, NM) do { _Pragma("unroll") for (int _i = 0; _i < 2; ++_i) { \
    const char* _b = (const char*)(gbase) + (_i ? p2##NM : (size_t)0); asm volatile("" : "+s"(_b));     \
    __builtin_amdgcn_global_load_lds((const unsigned*)(_b + voff##NM), (LAS unsigned*)(lds + (bufoff) + ldsw + _i * 8192), 16, 0, 0); } } while (0)
#define G8_LDA(dst, b, h) do { _Pragma("unroll") for (int m = 0; m < 4; ++m) { \
    if constexpr (FP8) dst##8[m] = cat8(*(const LAS bf16x8*)(lds + G8_SA(b, h) + aoff + m * 2048), *(const LAS bf16x8*)(lds + G8_SA(b, h) + aoff + m * 2048 + 1024)); \
    else { _Pragma("unroll") for (int k = 0; k < 2; ++k) dst[m][k] = *(const LAS bf16x8*)(lds + G8_SA(b, h) + aoff + m * 2048 + k * 1024); } } } while (0)
#define G8_LDB(dst, b, h) do { _Pragma("unroll") for (int n = 0; n < 2; ++n) { \
    if constexpr (FP8) dst##8[n] = cat8(*(const LAS bf16x8*)(lds + G8_SB(b, h) + boff + n * 2048), *(const LAS bf16x8*)(lds + G8_SB(b, h) + boff + n * 2048 + 1024)); \
    else { _Pragma("unroll") for (int k = 0; k < 2; ++k) dst[n][k] = *(const LAS bf16x8*)(lds + G8_SB(b, h) + boff + n * 2048 + k * 1024); } } } while (0)
#define G8_MMA(ai, bj, At, Bt) do { __builtin_amdgcn_s_setprio(1); _Pragma("unroll") for (int m = 0; m < 4; ++m) _Pragma("unroll") for (int n = 0; n < 2; ++n) { \
    if constexpr (FP8) acc[ai][bj][m][n] = __builtin_amdgcn_mfma_scale_f32_16x16x128_f8f6f4(Bt##8[n], At##8[m], acc[ai][bj][m][n], 0, 0, 0, 0, 0, 0); \
    else { _Pragma("unroll") for (int k = 0; k < 2; ++k) acc[ai][bj][m][n] = __builtin_amdgcn_mfma_f32_16x16x32_bf16(Bt[n][k], At[m][k], acc[ai][bj][m][n], 0, 0, 0); } } \
    __builtin_amdgcn_s_setprio(0); } while (0)
#define G8_WAIT_V(n) asm volatile("s_waitcnt vmcnt(" #n ")" ::: "memory")
#define G8_WAIT_L(n) asm volatile("s_waitcnt lgkmcnt(" #n ")" ::: "memory")
#define G8_BAR __builtin_amdgcn_s_barrier()
#define G8_SCHED __builtin_amdgcn_sched_barrier(0)
  GUnit cur, nxt; int ui = 0;
  if (!S.next(0, cur)) return;
  f32x4 acc[2][2][4][2];
#pragma unroll
  for (int a = 0; a < 2; ++a)
#pragma unroll
    for (int b = 0; b < 2; ++b)
#pragma unroll
      for (int m = 0; m < 4; ++m)
#pragma unroll
        for (int n = 0; n < 2; ++n) acc[a][b][m][n] = (f32x4){0.f, 0.f, 0.f, 0.f};
  bf16x8 At[4][2], B0[2][2], B1[2][2];
  v8i At8[4], B08[2], B18[2];
  const char* cA = cur.A; const char* cB = cur.B;
  G8_STAGE(G8_SB(0, 0), cB, B); G8_STAGE(G8_SB(0, 1), cB + hstepB, B); G8_STAGE(G8_SA(0, 0), cA, A); G8_STAGE(G8_SA(0, 1), cA + hstepA, A);
  if (wr == 1) G8_BAR;
  G8_WAIT_V(2); G8_BAR;
  G8_STAGE(G8_SB(1, 0), cB + kstep, B); G8_STAGE(G8_SA(1, 0), cA + kstep, A); G8_STAGE(G8_SB(1, 1), cB + hstepB + kstep, B);
  G8_WAIT_V(6); G8_BAR;
  for (;;) {
    const bool has_next = S.next(ui + 1, nxt);
    const char* nA = has_next ? nxt.A : cA; const char* nB = has_next ? nxt.B : cB;
    for (int t = 0; t < nt; t += 2) {
      const bool last = (t == nt - 2);
      const char* a1 = cA + (size_t)(t + 1) * kstep + hstepA;
      const char* a2 = last ? nA : cA + (size_t)(t + 2) * kstep; const char* b2 = last ? nB : cB + (size_t)(t + 2) * kstep;
      const char* a3 = a2 + kstep; const char* b3 = b2 + kstep;
      asm volatile("" : "+s"(a1), "+s"(a2), "+s"(b2), "+s"(a3), "+s"(b3));
      G8_LDB(B0, 0, 0); G8_LDB(B1, 0, 1); G8_SCHED; G8_LDA(At, 0, 0); G8_STAGE(G8_SA(1, 1), a1, A);
      const bool d0a = (BD == 0) || (BD == 1 && t < (nt >> 1)) || (BD == 2 && !(cur.pn & 1));
      const bool d1a = (BD == 0) || (BD == 1 && t >= (nt >> 1)) || (BD == 2 && !(cur.pn & 1));
      const bool d0b = (BD == 0) || (BD == 1 && t < (nt >> 1)) || (BD == 2 && (cur.pn & 1));
      const bool d1b = (BD == 0) || (BD == 1 && t >= (nt >> 1)) || (BD == 2 && (cur.pn & 1));
      G8_WAIT_V(8); G8_WAIT_L(0); G8_BAR; if (d0a) G8_MMA(0, 0, At, B0); if (d1a) G8_MMA(0, 1, At, B1); G8_BAR; G8_SCHED;
      G8_LDA(At, 0, 1); G8_STAGE(G8_SB(0, 0), b2, B); G8_STAGE(G8_SB(0, 1), b2 + hstepB, B); G8_STAGE(G8_SA(0, 0), a2, A);
      G8_WAIT_V(8); G8_WAIT_L(0); G8_BAR; if (d0a) G8_MMA(1, 0, At, B0); if (d1a) G8_MMA(1, 1, At, B1); G8_BAR; G8_SCHED;
      G8_LDB(B0, 1, 0); G8_LDB(B1, 1, 1); G8_SCHED; G8_LDA(At, 1, 0); G8_STAGE(G8_SA(0, 1), a2 + hstepA, A);
      G8_WAIT_V(8); G8_WAIT_L(0); G8_BAR; if (d0b) G8_MMA(0, 0, At, B0); if (d1b) G8_MMA(0, 1, At, B1); G8_BAR; G8_SCHED;
      G8_LDA(At, 1, 1); G8_STAGE(G8_SB(1, 0), b3, B); G8_STAGE(G8_SB(1, 1), b3 + hstepB, B); G8_STAGE(G8_SA(1, 0), a3, A);
      G8_WAIT_V(8); G8_WAIT_L(0); G8_BAR; if (d0b) G8_MMA(1, 0, At, B0); if (d1b) G8_MMA(1, 1, At, B1); G8_BAR; G8_SCHED;
    }
    if (wr == 0) G8_BAR;
    {
      int t2 = threadIdx.x; asm volatile("" : "+v"(t2));
      const int w2 = __builtin_amdgcn_readfirstlane(t2 >> 6), l2 = t2 & 63;
      E(acc, cur, w2 >> 2, w2 & 3, l2 & 15, l2 >> 4); }
    if (!has_next) break;
#pragma unroll
    for (int a = 0; a < 2; ++a)
#pragma unroll
      for (int b = 0; b < 2; ++b)
#pragma unroll
        for (int m = 0; m < 4; ++m)
#pragma unroll
          for (int n = 0; n < 2; ++n) acc[a][b][m][n] = (f32x4){0.f, 0.f, 0.f, 0.f};
    cur = nxt; cA = nA; cB = nB; ++ui;
    if (wr == 1) G8_BAR;
  }
  G8_WAIT_V(0);
  G8_BAR;
#undef G8_SA
#undef G8_SB
#undef G8_STAGE
#undef G8_LDA
#undef G8_LDB
#undef G8_MMA
#undef G8_WAIT_V
#undef G8_WAIT_L
#undef G8_BAR
#undef G8_SCHED
}

typedef f32x4 Acc[2][2][4][2];

struct EpiProjA {
  const float* ss0; bf16_t* q; bf16_t* z; float* ckv; bf16_t* qidx; bf16_t* kidx; float* widx; const float* kg; int pnoff; float osc;
  __device__ __forceinline__ void operator()(const Acc& acc, const GUnit& u, int wr, int wc, int fr, int fq) const {
    const int row0 = u.pm * 256 + wr * 64 + fr, pn = u.pn + pnoff;
#pragma unroll
    for (int ai = 0; ai < 2; ++ai)
#pragma unroll
      for (int m = 0; m < 4; ++m) {
        const int row = row0 + ai * 128 + m * 16;
        const float rs = rsqrtf(ss0[row] * (1.f / 2048.f) + EPS) * osc;
        if (pn < 32) {
          unsigned char* base = (unsigned char*)(pn < 16 ? q : z) + (size_t)row * 4096 + (pn & 15) * 256 + wc * 32 + 8 * fq;
#pragma unroll
          for (int bj = 0; bj < 2; ++bj) { const f32x4 a = acc[ai][bj][m][0] * rs, b = acc[ai][bj][m][1] * rs; u32x2 w;
            w[0] = __builtin_amdgcn_cvt_pk_fp8_f32(a[0], a[1], 0, false); w[0] = __builtin_amdgcn_cvt_pk_fp8_f32(a[2], a[3], w[0], true);
            w[1] = __builtin_amdgcn_cvt_pk_fp8_f32(b[0], b[1], 0, false); w[1] = __builtin_amdgcn_cvt_pk_fp8_f32(b[2], b[3], w[1], true);
            *(u32x2*)(base + bj * 128) = w; }
        } else if (pn == 32) {
          float* base = ckv + (size_t)row * 256 + wc * 32 + 8 * fq;
#pragma unroll
          for (int bj = 0; bj < 2; ++bj) { *(f32x4*)(base + bj * 128) = acc[ai][bj][m][0] * rs; *(f32x4*)(base + bj * 128 + 4) = acc[ai][bj][m][1] * rs; }
        } else if (pn < 37) {
          bf16_t* base = qidx + (size_t)row * 1024 + (pn - 33) * 256 + wc * 32 + 8 * fq;
#pragma unroll
          for (int bj = 0; bj < 2; ++bj) *(u32x4*)(base + bj * 128) = pack8(acc[ai][bj][m][0] * rs, acc[ai][bj][m][1] * rs);
        } else {
          if (wc == 0) {
            f32x4 v[2][2]; float s = 0.f;
#pragma unroll
            for (int bj = 0; bj < 2; ++bj)
#pragma unroll
              for (int n = 0; n < 2; ++n) { v[bj][n] = acc[ai][bj][m][n] * rs; s += v[bj][n][0] * v[bj][n][0] + v[bj][n][1] * v[bj][n][1] + v[bj][n][2] * v[bj][n][2] + v[bj][n][3] * v[bj][n][3]; }
            s = psum32(psum16(s));
            const float kr = rsqrtf(s * (1.f / 64.f) + EPS);
#pragma unroll
            for (int bj = 0; bj < 2; ++bj) {
              const f32x4 g0 = *(const f32x4*)(kg + 32 * bj + 8 * fq), g1 = *(const f32x4*)(kg + 32 * bj + 8 * fq + 4);
              *(u32x4*)(kidx + ((size_t)(row >> 5) * 4 + 2 * bj + (fq >> 1)) * 512 + ((fq & 1) * 32 + (row & 31)) * 8) = pack8(v[bj][0] * kr * g0, v[bj][1] * kr * g1);
            }
          } else if (wc == 1 && fq < 2) {
            float* base = widx + (size_t)row * 16 + 8 * fq;
            *(f32x4*)(base) = acc[ai][0][m][0] * (rs * 0.25f); *(f32x4*)(base + 4) = acc[ai][0][m][1] * (rs * 0.25f);
          }
        }
      }
  }
};

struct EpiBf16 {
  bf16_t* O0; bf16_t* O1; int nsplit; int ld; const float* ss;
  __device__ __forceinline__ void operator()(const Acc& acc, const GUnit& u, int wr, int wc, int fr, int fq) const {
    const int row0 = u.pm * 256 + wr * 64 + fr;
    bf16_t* ob = (u.pn < nsplit ? O0 + (size_t)u.pn * 256 : O1 + (size_t)(u.pn - nsplit) * 256) + wc * 32 + 8 * fq;
#pragma unroll
    for (int ai = 0; ai < 2; ++ai)
#pragma unroll
      for (int m = 0; m < 4; ++m) {
        const int row = row0 + ai * 128 + m * 16;
        const float rs = ss ? rsqrtf(ss[row] * (1.f / 2048.f) + EPS) : 1.f;
#pragma unroll
        for (int bj = 0; bj < 2; ++bj) *(u32x4*)(ob + (size_t)row * ld + bj * 128) = pack8(acc[ai][bj][m][0] * rs, acc[ai][bj][m][1] * rs);
      }
  }
};

struct EpiQlat {
  unsigned char* Q0; float osc;
  __device__ __forceinline__ void operator()(const Acc& acc, const GUnit& u, int wr, int wc, int fr, int fq) const {
    const int row0 = u.pm * 256 + wr * 64 + fr;
    unsigned char* ob = Q0 + (size_t)u.pn * 256 + wc * 32 + 8 * fq;
#pragma unroll
    for (int ai = 0; ai < 2; ++ai)
#pragma unroll
      for (int m = 0; m < 4; ++m) {
        const int row = row0 + ai * 128 + m * 16;
#pragma unroll
        for (int bj = 0; bj < 2; ++bj) { const f32x4 a = acc[ai][bj][m][0] * osc, b = acc[ai][bj][m][1] * osc; u32x2 w;
          w[0] = __builtin_amdgcn_cvt_pk_fp8_f32(a[0], a[1], 0, false); w[0] = __builtin_amdgcn_cvt_pk_fp8_f32(a[2], a[3], w[0], true);
          w[1] = __builtin_amdgcn_cvt_pk_fp8_f32(b[0], b[1], 0, false); w[1] = __builtin_amdgcn_cvt_pk_fp8_f32(b[2], b[3], w[1], true);
          *(u32x2*)(ob + (size_t)row * 8192 + bj * 128) = w; }
      }
  }
};

struct EpiGate {
  unsigned char* Y; const unsigned char* Z; float osc;
  __device__ __forceinline__ void operator()(const Acc& acc, const GUnit& u, int wr, int wc, int fr, int fq) const {
    const int row0 = u.pm * 256 + wr * 64 + fr; const int col0 = u.pn * 256 + wc * 32 + 8 * fq;
#pragma unroll
    for (int ai = 0; ai < 2; ++ai)
#pragma unroll
      for (int m = 0; m < 4; ++m) {
        const size_t off = (size_t)(row0 + ai * 128 + m * 16) * 4096 + col0;
#pragma unroll
        for (int bj = 0; bj < 2; ++bj) {
          const u32x2 zw = *(const u32x2*)(Z + off + bj * 128);
          typedef float f32x2v __attribute__((ext_vector_type(2)));
          const f32x2v z0 = __builtin_amdgcn_cvt_pk_f32_fp8(zw[0], false), z1 = __builtin_amdgcn_cvt_pk_f32_fp8(zw[0], true), z2 = __builtin_amdgcn_cvt_pk_f32_fp8(zw[1], false), z3 = __builtin_amdgcn_cvt_pk_f32_fp8(zw[1], true);
          f32x4 a = acc[ai][bj][m][0] * osc, b = acc[ai][bj][m][1] * osc;
          a[0] *= silu_fast(z0[0]); a[1] *= silu_fast(z0[1]); a[2] *= silu_fast(z1[0]); a[3] *= silu_fast(z1[1]);
          b[0] *= silu_fast(z2[0]); b[1] *= silu_fast(z2[1]); b[2] *= silu_fast(z3[0]); b[3] *= silu_fast(z3[1]);
          u32x2 w; w[0] = __builtin_amdgcn_cvt_pk_fp8_f32(a[0], a[1], 0, false); w[0] = __builtin_amdgcn_cvt_pk_fp8_f32(a[2], a[3], w[0], true);
          w[1] = __builtin_amdgcn_cvt_pk_fp8_f32(b[0], b[1], 0, false); w[1] = __builtin_amdgcn_cvt_pk_fp8_f32(b[2], b[3], w[1], true);
          *(u32x2*)(Y + off + bj * 128) = w;
        }
      }
  }
};

struct EpiRes {
  const float* R; const bf16_t* RB; int ldrb; float* H; bf16_t* HB; int ldhb; float* ss; float osc;
  __device__ __forceinline__ void operator()(const Acc& acc, const GUnit& u, int wr, int wc, int fr, int fq) const {
    const int row0 = u.pm * 256 + wr * 64 + fr; const int col0 = u.pn * 256 + wc * 32 + 8 * fq;
#pragma unroll
    for (int ai = 0; ai < 2; ++ai)
#pragma unroll
      for (int m = 0; m < 4; ++m) {
        const int row = row0 + ai * 128 + m * 16; const size_t off = (size_t)row * 2048 + col0; float s = 0.f;
#pragma unroll
        for (int bj = 0; bj < 2; ++bj) {
          f32x4 r0, r1;
          if (R) { r0 = *(const f32x4*)(R + off + bj * 128); r1 = *(const f32x4*)(R + off + bj * 128 + 4); }
          else { const u32x4 rw = *(const u32x4*)(RB + (size_t)row * ldrb + col0 + bj * 128);
            r0 = (f32x4){bflo(rw[0]), bfhi(rw[0]), bflo(rw[1]), bfhi(rw[1])}; r1 = (f32x4){bflo(rw[2]), bfhi(rw[2]), bflo(rw[3]), bfhi(rw[3])}; }
          const f32x4 h0 = r0 + acc[ai][bj][m][0] * osc, h1 = r1 + acc[ai][bj][m][1] * osc;
          if (H) { *(f32x4*)(H + off + bj * 128) = h0; *(f32x4*)(H + off + bj * 128 + 4) = h1; }
          if (HB) *(u32x4*)(HB + (size_t)row * ldhb + col0 + bj * 128) = pack8(h0, h1);
          s += h0[0] * h0[0] + h0[1] * h0[1] + h0[2] * h0[2] + h0[3] * h0[3] + h1[0] * h1[0] + h1[1] * h1[1] + h1[2] * h1[2] + h1[3] * h1[3];
        }
        s = psum32(psum16(s));
        if (fq == 0) atomicAdd(ss + row, s);
      }
  }
};
}

struct CmA { __device__ __forceinline__ int operator()(int n) const {
  if (n < 4096) return n;
  if (n < 8192) return 5456 + (n - 4096);
  if (n < 8448) return 4096 + (n - 8192);
  if (n < 9472) return 4352 + (n - 8448);
  const int c = n - 9472;
  if (c < 32) return 5376 + c;
  if (c < 48) return 5440 + (c - 32);
  if (c >= 128 && c < 160) return 5376 + 32 + (c - 128);
  return -1; } };
struct CmAI { __device__ __forceinline__ int operator()(int n) const { return CmA{}(n + 8192); } };
struct CmOff { int off; __device__ __forceinline__ int operator()(int n) const { return n + off; } };

template <class CM, bool FP8 = false>
__device__ __forceinline__ void tconv_tile(bf16_t* dst, int ldD, const float* src, int ldS, int kt, int np, const float* gk, CM cm, float* tl, int tid, float wsc = 1.f) {
  {
    { const int c = tid & 63, r = tid >> 6; const int sc0 = cm(np * 128 + c), sc1 = cm(np * 128 + 64 + c);
      float v0[8], v1[8];
#pragma unroll
      for (int pass = 0; pass < 8; ++pass) { const int k = kt * 64 + pass * 8 + r; const float g = (gk ? gk[k] : 1.f) * wsc;
        v0[pass] = (sc0 >= 0) ? src[(size_t)k * ldS + sc0] * g : 0.f; v1[pass] = (sc1 >= 0) ? src[(size_t)k * ldS + sc1] * g : 0.f; }
#pragma unroll
      for (int pass = 0; pass < 8; ++pass) { tl[(pass * 8 + r) * 129 + c] = v0[pass]; tl[(pass * 8 + r) * 129 + 64 + c] = v1[pass]; } }
    __syncthreads();
#pragma unroll
    for (int hf = 0; hf < 2; ++hf) { const int nl = hf * 64 + (tid >> 3), kc = tid & 7; float v[8];
#pragma unroll
      for (int j = 0; j < 8; ++j) v[j] = tl[(kc * 8 + j) * 129 + nl];
      if constexpr (FP8) {
        u32x2 w; w[0] = __builtin_amdgcn_cvt_pk_fp8_f32(v[0], v[1], 0, false); w[0] = __builtin_amdgcn_cvt_pk_fp8_f32(v[2], v[3], w[0], true);
        w[1] = __builtin_amdgcn_cvt_pk_fp8_f32(v[4], v[5], 0, false); w[1] = __builtin_amdgcn_cvt_pk_fp8_f32(v[6], v[7], w[1], true);
        *(u32x2*)((unsigned char*)dst + (size_t)(np * 128 + nl) * ldD + kt * 64 + kc * 8) = w;
      } else {
      u32x4 w; w[0] = cvt_pk_bf16(v[0], v[1]); w[1] = cvt_pk_bf16(v[2], v[3]); w[2] = cvt_pk_bf16(v[4], v[5]); w[3] = cvt_pk_bf16(v[6], v[7]);
      *(u32x4*)(dst + (size_t)(np * 128 + nl) * ldD + kt * 64 + kc * 8) = w; } }
    __syncthreads();
  }
}
template <class CM, bool FP8 = false>
__device__ __forceinline__ void tconv(bf16_t* dst, int ldD, const float* src, int ldS, int Ktiles, int Ntiles, const float* gk, CM cm, float* tl, int bid, int nb, float wsc = 1.f) {
  int tid = threadIdx.x; asm volatile("" : "+v"(tid));
  const int Np = Ntiles >> 1;
  for (int tile = bid; tile < Ktiles * Np; tile += nb) tconv_tile<CM, FP8>(dst, ldD, src, ldS, tile / Np, tile % Np, gk, cm, tl, tid, wsc);
}

__device__ __forceinline__ void p0_prep(const Params& p, unsigned char* lds, int bid, int nb) {
  int tid = threadIdx.x; asm volatile("" : "+v"(tid));
  const int lane = tid & 63, wid = tid >> 6;
  float* tl = (float*)lds;
  unsigned char* ws = p.ws;
  { bf16_t* xb = (bf16_t*)(ws + OFF_QL0); unsigned char* xq = ws + OFF_XQ; float* ss0 = (float*)(ws + OFF_SS);
    for (int row = bid * 8 + wid; row < T; row += nb * 8) {
      const f32x4* src = (const f32x4*)(p.x + (size_t)row * D); float s = 0.f;
#pragma unroll
      for (int j = 0; j < 8; ++j) { const f32x4 v = src[lane + 64 * j]; s += v[0] * v[0] + v[1] * v[1] + v[2] * v[2] + v[3] * v[3];
        u32x2 o; o[0] = cvt_pk_bf16(v[0], v[1]); o[1] = cvt_pk_bf16(v[2], v[3]); *(u32x2*)(xb + (size_t)row * D + (lane + 64 * j) * 4) = o;
        unsigned q8 = __builtin_amdgcn_cvt_pk_fp8_f32(v[0], v[1], 0, false); q8 = __builtin_amdgcn_cvt_pk_fp8_f32(v[2], v[3], q8, true); *(unsigned*)(xq + (size_t)row * D + (lane + 64 * j) * 4) = q8; }
      s = wave_sum(s, lane); if (lane == 0) ss0[row] = s;
    }
    for (int i = bid * 512 + tid; i < 2 * T; i += nb * 512) ss0[T + i] = 0.f;
    { float* sm = (float*)(ws + OFF_SMALL);
      for (int i = bid * 512 + tid; i < SM_TOTAL; i += nb * 512) {
        float v;
        if (i < SM_KVN) v = p.kidx_norm[i]; else if (i < SM_RELB) v = p.kv_norm[i - SM_KVN]; else if (i < SM_BGRP) v = p.rel_bias[i - SM_RELB];
        else if (i < SM_SCALE) v = p.b_grp[i - SM_BGRP]; else if (i < SM_FINAL) v = p.scale_b[i - SM_SCALE]; else v = p.final_norm[i - SM_FINAL];
        sm[i] = v; } } }
  tconv<CmA, true>((bf16_t*)(ws + OFF_WA), 2048, p.w_in_a, 9552, 32, 128, p.norm_a, CmA{}, tl, bid, nb, 64.f);
  tconv((bf16_t*)(ws + OFF_WAI), 2048, p.w_in_a, 9552, 32, 24, p.norm_a, CmAI{}, tl, bid, nb);
  tconv<CmOff, true>((bf16_t*)(ws + OFF_WOUTA), 4096, p.w_out_a, 2048, 64, 32, nullptr, CmOff{0}, tl, bid, nb, 64.f);
  tconv((bf16_t*)(ws + OFF_WB) + (size_t)4096 * LDWB, LDWB, p.w_in_b, 8192, 32, 64, p.norm_b, CmOff{4096}, tl, bid, nb);
  for (int it = bid; it < 512; it += nb) { const int g = it >> 7, rem = it & 127;
    tconv_tile((bf16_t*)(ws + OFF_WG) + (size_t)g * 1048576, 1024, p.w_grp + (size_t)g * 1048576, 1024, rem >> 3, rem & 7, nullptr, CmOff{0}, tl, tid); }
  tconv((bf16_t*)(ws + OFF_WOUTB), 4096, p.w_out_b, 2048, 64, 32, nullptr, CmOff{0}, tl, bid, nb);
  for (int it = (bid + (nb >> 1)) % nb; it < 128; it += nb) {
    const int h = it >> 2, pair = h >> 1, hh = h & 1;
    tconv_tile<CmOff, true>((bf16_t*)(ws + OFF_WUV + (size_t)pair * 131072 + (size_t)hh * 128 * 512 + hh * 256), 512, p.w_uv + h * 128, 4096, it & 3, 0, nullptr, CmOff{0}, tl, tid, 16.f);
  }
  {
    unsigned char* wv = ws + OFF_WUV;
    for (int i = bid * 512 + tid; i < 32 * 128 * 16; i += nb * 512) {
      const int piece = i & 15, r = (i >> 4) & 127, ph = i >> 11; const int pair = ph >> 1, hh = ph & 1;
      *(u32x4*)(wv + (size_t)pair * 131072 + (size_t)(hh * 128 + r) * 512 + (1 - hh) * 256 + piece * 16) = (u32x4){0u, 0u, 0u, 0u};
    } }
  {
    bf16_t* wu = (bf16_t*)(ws + OFF_WU);
    for (int i = bid * 512 + tid; i < 4 * 2048 * 256; i += nb * 512) {
      const int p4 = i & 255, k = (i >> 8) & 2047, g = i >> 19;
      const f32x4 v = *(const f32x4*)(p.w_in_b + (size_t)k * 8192 + g * 1024 + p4 * 4) * p.norm_b[k];
      u32x2 o; o[0] = cvt_pk_bf16(v[0], v[1]); o[1] = cvt_pk_bf16(v[2], v[3]); *(u32x2*)(wu + (size_t)g * 2097152 + (size_t)k * 1024 + p4 * 4) = o;
    } }
  {
    unsigned char* wk = ws + OFF_WUK;
    for (int i = bid * 512 + tid; i < 16 * 512 * 64; i += nb * 512) {
      const int k4 = i & 63, n = (i >> 6) & 511, pr = i >> 15; const int hh = n >> 8, c = n & 255;
      unsigned w = 0u;
      if ((k4 >> 5) == hh) { const f32x4 v = *(const f32x4*)(p.w_uk + (size_t)c * 4096 + (2 * pr + hh) * 128 + (k4 & 31) * 4) * 16.f;
        w = __builtin_amdgcn_cvt_pk_fp8_f32(v[0], v[1], 0, false); w = __builtin_amdgcn_cvt_pk_fp8_f32(v[2], v[3], w, true); }
      *(unsigned*)(wk + (size_t)pr * 131072 + (size_t)n * 256 + k4 * 4) = w;
    } }
}

__device__ __forceinline__ void p3_ckvnorm(const Params& p, int bid, int nb) {
  int tid = threadIdx.x; asm volatile("" : "+v"(tid));
  const int lane = tid & 63, wid = tid >> 6;
  const float* cr = (const float*)(p.ws + OFF_CKVR); bf16_t* cn = (bf16_t*)(p.ws + OFF_CKVN);
  const f32x4 g = *(const f32x4*)((const float*)(p.ws + OFF_SMALL) + SM_KVN + lane * 4);
  for (int row = bid * 8 + wid; row < T; row += nb * 8) {
    const f32x4 v = *(const f32x4*)(cr + (size_t)row * 256 + lane * 4);
    float s = v[0] * v[0] + v[1] * v[1] + v[2] * v[2] + v[3] * v[3]; s = wave_sum(s, lane);
    const float r = rsqrtf(s * (1.f / 256.f) + EPS);
    u32x2 o; o[0] = cvt_pk_bf16(v[0] * r * g[0], v[1] * r * g[1]); o[1] = cvt_pk_bf16(v[2] * r * g[2], v[3] * r * g[3]);
    *(u32x2*)(cn + (size_t)row * 256 + lane * 4) = o;
  }
}

__device__ __forceinline__ void p3_indexer(const Params& p, unsigned char* lds, int bid, int nb, int rep_sc, int rep_sel) {
  float* sc = (float*)lds;
  const bf16_t* qidx = (const bf16_t*)(p.ws + OFF_QIDX); const bf16_t* kidx = (const bf16_t*)(p.ws + OFF_KIDX); const float* widx = (const float*)(p.ws + OFF_WIDX);
  unsigned short* idxo = (unsigned short*)(p.ws + OFF_IDX);
  int tid = threadIdx.x; asm volatile("" : "+v"(tid));
  const int lane = tid & 63, wid = tid >> 6, h = lane >> 5, l31 = lane & 31;
  for (int round = 0; round * nb + bid < T / 16; ++round) {
    const int item = round * nb + bid;
    const int b = item & 15; int tile = item >> 4; { const int r16 = tile >> 4, j = tile & 15; tile = r16 * 16 + ((r16 & 1) ? 15 - j : j); }
    const int t0 = tile * 16;
    if (t0 < 256) {
      const int tok = tid >> 5, j0 = (tid & 31) * 8, t = t0 + tok;
      unsigned short v[8];
#pragma unroll
      for (int j = 0; j < 8; ++j) v[j] = (unsigned short)((j0 + j <= t) ? (j0 + j) : 0);
      u32x4 w; w[0] = v[0] | ((unsigned)v[1] << 16); w[1] = v[2] | ((unsigned)v[3] << 16); w[2] = v[4] | ((unsigned)v[5] << 16); w[3] = v[6] | ((unsigned)v[7] << 16);
      *(u32x4*)(idxo + (size_t)(b * L + t) * 256 + j0) = w;
      continue;
    }
    for (int rsc = 0; rsc < rep_sc; ++rsc) {
      const int tok = l31 >> 4, head = l31 & 15;
      const bf16_t* arow = qidx + (size_t)(b * L + t0 + 2 * wid + tok) * 1024 + head * 64 + 8 * h;
      bf16x8 aq[4];
#pragma unroll
      for (int ks = 0; ks < 4; ++ks) aq[ks] = *(const bf16x8*)(arow + 16 * ks);
      float wv[16];
#pragma unroll
      for (int tk = 0; tk < 2; ++tk) {
        const float* wp = widx + (size_t)(b * L + t0 + 2 * wid + tk) * 16 + 4 * h;
        const f32x4 w0 = *(const f32x4*)(wp), w1 = *(const f32x4*)(wp + 8);
#pragma unroll
        for (int i = 0; i < 4; ++i) { wv[tk * 8 + i] = w0[i] * 0.125f; wv[tk * 8 + 4 + i] = w1[i] * 0.125f; }
      }
      const unsigned char* kb = (const unsigned char*)(kidx + (size_t)b * 64 * 2048) + tid * 16;
      LAS unsigned char* stgb = (LAS unsigned char*)lds + 131072;
      const int nkt = ((t0 + 15) >> 5) + 1, ngr = (nkt + 1) >> 1;
      u32x4 sv = *(const u32x4*)(kb);
      *(LAS u32x4*)(stgb + tid * 16) = sv;
      if (ngr > 1) sv = *(const u32x4*)(kb + 8192);
      __syncthreads();
      for (int gr = 0; gr < ngr; ++gr) {
        if (gr + 1 < ngr) *(LAS u32x4*)(stgb + ((gr + 1) & 1) * 8192 + tid * 16) = sv;
        if (gr + 2 < ngr) sv = *(const u32x4*)(kb + (size_t)(gr + 2) * 8192);
        const LAS unsigned char* bb = stgb + (gr & 1) * 8192 + lane * 16;
#pragma unroll
        for (int q = 0; q < 2; ++q) {
          f32x16 acc;
#pragma unroll
          for (int i = 0; i < 16; ++i) acc[i] = 0.f;
#pragma unroll
          for (int ks = 0; ks < 4; ++ks) { const bf16x8 bfr = *(const LAS bf16x8*)(bb + q * 4096 + ks * 1024); acc = __builtin_amdgcn_mfma_f32_32x32x16_bf16(aq[ks], bfr, acc, 0, 0, 0); }
          float s0 = 0.f, s1 = 0.f;
#pragma unroll
          for (int i = 0; i < 8; ++i) { s0 += wv[i] * relu_i(acc[i]); s1 += wv[8 + i] * relu_i(acc[8 + i]); }
          s0 = psum32(s0); s1 = psum32(s1);
          sc[(2 * wid + h) * 2048 + 32 * (2 * gr + q) + l31] = h ? s1 : s0;
        }
        __syncthreads();
      }
    }
    __syncthreads();
    LAS unsigned* hist = (LAS unsigned*)((LAS unsigned char*)lds + 131072) + wid * 256;
    LAS unsigned* cand = (LAS unsigned*)((LAS unsigned char*)lds + 131072 + 8192) + wid * 128;
    for (int rsel = 0; rsel < rep_sel; ++rsel)
    for (int qq = 0; qq < 2; ++qq) {
      const int qi = 2 * wid + qq, t = t0 + qi;
      float v[32];
#pragma unroll
      for (int j = 0; j < 32; ++j) v[j] = sc[qi * 2048 + lane + 64 * j];
      float mn = 3.0e38f, mx = -3.0e38f;
#pragma unroll
      for (int j = 0; j < 32; ++j) { const bool valid = (lane + 64 * j) <= t; mn = valid ? fminf(mn, v[j]) : mn; mx = valid ? fmaxf(mx, v[j]) : mx; }
      mn = wave_min(mn); mx = wave_max(mx);
      const float scale = (mx > mn) ? 255.f / (mx - mn) : 0.f;
      *(LAS u32x4*)(hist + lane * 4) = (u32x4){0u, 0u, 0u, 0u};
      asm volatile("" ::: "memory");
#pragma unroll
      for (int j = 0; j < 32; ++j) { const bool valid = (lane + 64 * j) <= t; const int bin = min((int)((v[j] - mn) * scale), 255);
        if (valid) __hip_atomic_fetch_add(hist + bin, 1u, __ATOMIC_RELAXED, __HIP_MEMORY_SCOPE_WORKGROUP); }
      asm volatile("s_waitcnt lgkmcnt(0)" ::: "memory");
      const u32x4 h4 = *(const LAS u32x4*)(hist + lane * 4);
      const int tot = (int)(h4[0] + h4[1] + h4[2] + h4[3]);
      int px = tot;
      px += __builtin_amdgcn_update_dpp(0, px, 0x111, 0xf, 0xf, true); px += __builtin_amdgcn_update_dpp(0, px, 0x112, 0xf, 0xf, true);
      px += __builtin_amdgcn_update_dpp(0, px, 0x114, 0xf, 0xf, true); px += __builtin_amdgcn_update_dpp(0, px, 0x118, 0xf, 0xf, true);
      const int rt0 = __builtin_amdgcn_readlane(px, 15), rt1 = __builtin_amdgcn_readlane(px, 31), rt2 = __builtin_amdgcn_readlane(px, 47), rt3 = __builtin_amdgcn_readlane(px, 63);
      const int pre = px + (lane >= 16 ? rt0 : 0) + (lane >= 32 ? rt1 : 0) + (lane >= 48 ? rt2 : 0);
      const int suf = (rt0 + rt1 + rt2 + rt3) - pre + tot;
      const int S3 = suf - tot + (int)h4[3], S2 = S3 + (int)h4[2], S1 = S2 + (int)h4[1], S0 = S1 + (int)h4[0];
      const unsigned long long bm = __ballot(S0 >= 256);
      const int lstar = 63 - __clzll(bm);
      const int myB = S3 >= 256 ? 3 : (S2 >= 256 ? 2 : (S1 >= 256 ? 1 : 0));
      const int mySB = S3 >= 256 ? S3 : (S2 >= 256 ? S2 : (S1 >= 256 ? S1 : S0));
      const int myh = (int)(S3 >= 256 ? h4[3] : (S2 >= 256 ? h4[2] : (S1 >= 256 ? h4[1] : h4[0])));
      const int B = lstar * 4 + __builtin_amdgcn_readlane(myB, lstar);
      const int m = __builtin_amdgcn_readlane(myh, lstar);
      const int c_hi = __builtin_amdgcn_readlane(mySB, lstar) - m, need = 256 - c_hi;
      unsigned short* op = idxo + (size_t)(b * L + t) * 256;
      int base = 0, cbn = 0;
#pragma unroll
      for (int j = 0; j < 32; ++j) {
        const int e = lane + 64 * j; const bool valid = e <= t; const int bin = min((int)((v[j] - mn) * scale), 255);
        const bool hi = valid && bin > B, eq = valid && bin == B;
        const unsigned long long hm = __ballot(hi), em = __ballot(eq);
        const int pos = base + (int)__builtin_amdgcn_mbcnt_hi((unsigned)(hm >> 32), __builtin_amdgcn_mbcnt_lo((unsigned)hm, 0u));
        const int cpos = cbn + (int)__builtin_amdgcn_mbcnt_hi((unsigned)(em >> 32), __builtin_amdgcn_mbcnt_lo((unsigned)em, 0u));
        if (hi && pos < 256) op[pos] = (unsigned short)e;
        if (eq && cpos < 64) { const unsigned bits = __float_as_uint(v[j]); cand[2 * cpos] = bits ^ ((bits >> 31) ? 0xFFFFFFFFu : 0x80000000u); cand[2 * cpos + 1] = (unsigned)e; }
        base += __popcll(hm); cbn += __popcll(em);
      }
      if (m <= 64) {
        asm volatile("s_waitcnt lgkmcnt(0)" ::: "memory");
        const unsigned ck = (lane < m) ? cand[2 * lane] : 0u, ce = (lane < m) ? cand[2 * lane + 1] : 0xffffu;
        int rank = 0;
        for (int jj = 0; jj < m; ++jj) { const unsigned kj = __builtin_amdgcn_readlane(ck, jj), ej = __builtin_amdgcn_readlane(ce, jj); rank += (kj > ck || (kj == ck && ej < ce)) ? 1 : 0; }
        const bool selc = (lane < m) && (rank < need);
        const unsigned long long sm = __ballot(selc);
        const int pos = c_hi + (int)__builtin_amdgcn_mbcnt_hi((unsigned)(sm >> 32), __builtin_amdgcn_mbcnt_lo((unsigned)sm, 0u));
        if (selc && pos < 256) op[pos] = (unsigned short)ce;
      } else {
#define KEYOF(j) (((lane + 64 * (j)) <= t) ? (__float_as_uint(v[j]) ^ ((__float_as_uint(v[j]) >> 31) ? 0xFFFFFFFFu : 0x80000000u)) : 0u)
        unsigned prefix = 0u;
        for (int bit = 31; bit >= 0; --bit) {
          const unsigned cnd = prefix | (1u << bit); int cnt = 0;
#pragma unroll
          for (int j = 0; j < 32; ++j) cnt += __popcll(__ballot(KEYOF(j) >= cnd));
          if (cnt >= 256) prefix = cnd;
        }
        int cgt = 0;
#pragma unroll
        for (int j = 0; j < 32; ++j) cgt += __popcll(__ballot(KEYOF(j) > prefix));
        const int need2 = 256 - cgt; int base2 = 0, tb = 0;
#pragma unroll
        for (int j = 0; j < 32; ++j) {
          const unsigned uj = KEYOF(j); const bool gt = uj > prefix, eq = (uj == prefix);
          const unsigned long long eqm = __ballot(eq);
          const int trank = tb + (int)__builtin_amdgcn_mbcnt_hi((unsigned)(eqm >> 32), __builtin_amdgcn_mbcnt_lo((unsigned)eqm, 0u));
          const bool sel = gt || (eq && trank < need2);
          const unsigned long long sm = __ballot(sel);
          const int pos = base2 + (int)__builtin_amdgcn_mbcnt_hi((unsigned)(sm >> 32), __builtin_amdgcn_mbcnt_lo((unsigned)sm, 0u));
          if (sel && pos < 256) op[pos] = (unsigned short)(lane + 64 * j);
          base2 += __popcll(sm); tb += __popcll(eqm);
        }
#undef KEYOF
      }
    }
    __syncthreads();
  }
}

__device__ __forceinline__ void pair_sync(LAS unsigned* cnt, unsigned target, int lane) {
  asm volatile("" ::: "memory");
  if (lane == 0) __hip_atomic_fetch_add(cnt, 1u, __ATOMIC_RELAXED, __HIP_MEMORY_SCOPE_WORKGROUP);
  while (__hip_atomic_load(cnt, __ATOMIC_RELAXED, __HIP_MEMORY_SCOPE_WORKGROUP) < target) __builtin_amdgcn_s_sleep(1);
  asm volatile("" ::: "memory");
}
constexpr int CROW = 544;
constexpr int CTOK = 32 * CROW;
constexpr int CBUF = 4 * CTOK;
__device__ __forceinline__ void p4_attn(const Params& p, unsigned char* lds, int bid, int nb, bool dry) {
  LAS unsigned char* cbuf = (LAS unsigned char*)lds;
  LAS float* biasd = (LAS float*)((LAS unsigned char*)lds + 2 * CBUF);
  LAS unsigned short* idxs = (LAS unsigned short*)((LAS unsigned char*)lds + 2 * CBUF + 129 * 32 * 4);
  const bf16_t* ckvn = (const bf16_t*)(p.ws + OFF_CKVN); const unsigned short* idxg = (const unsigned short*)(p.ws + OFF_IDX);
  unsigned char* QL = p.ws + OFF_QL0;
  int tid = threadIdx.x; asm volatile("" : "+v"(tid));
  const int lane = tid & 63, wid = __builtin_amdgcn_readfirstlane(tid >> 6), g = lane >> 4, r16 = lane & 15;
  for (int i = tid; i < 129 * 32; i += 512) {
    const int d = i >> 5, hd = i & 31; int bucket = d;
    if (d >= 16) { bucket = 16 + (d >= 19) + (d >= 21) + (d >= 24) + (d >= 27) + (d >= 31) + (d >= 35) + (d >= 40) + (d >= 46) + (d >= 52) + (d >= 59) + (d >= 67) + (d >= 77) + (d >= 87) + (d >= 99) + (d >= 113); }
    biasd[i] = ((const float*)(p.ws + OFF_SMALL))[SM_RELB + bucket * 32 + hd] * LOG2E;
  }
  LAS unsigned* pcnt = (LAS unsigned*)((LAS unsigned char*)lds + 2 * CBUF + 129 * 32 * 4 + 2048) + (wid >> 1);
  if (tid < 4) ((LAS unsigned*)((LAS unsigned char*)lds + 2 * CBUF + 129 * 32 * 4 + 2048))[tid] = 0u;
  __syncthreads();
  unsigned epoch = 0u;
  const int tok = wid >> 1, hw = wid & 1, head = hw * 16 + r16;
  const float SC = 0.08838834764831845f * LOG2E;
  const int qoff = 16 * (g ^ (r16 >> 3));
  const int q4 = r16 >> 2, pp = r16 & 3;
  const int troff = (4 * g + q4) * CROW + 16 * ((pp >> 1) ^ (g >> 1)) + 8 * (pp & 1);
  const int wrow = 16 * hw + 8 * (lane >> 5), wch = lane & 31;
  for (int round = 0; round * nb < T / 4; ++round) {
    const int item = round * nb + (bid + round * 37) % nb;
    const int tg0 = item * 4, b = tg0 >> 11, t0 = tg0 & 2047, t = t0 + tok, tg = tg0 + tok;
    const int nk = min(t + 1, 256), nkmax = min(t0 + 4, 256), nch = (nkmax + 31) >> 5;
    ((LAS unsigned*)idxs)[tid] = ((const unsigned*)(idxg + (size_t)tg0 * 256))[tid];
    unsigned char* qrow = QL + (size_t)tg * 8192 + head * 256;
    bf16x8 qB[8];
#pragma unroll
    for (int s = 0; s < 8; ++s) { const u32x2 qw = *(const u32x2*)(qrow + 32 * s + 8 * g);
      typedef float f32x2v __attribute__((ext_vector_type(2)));
      const f32x2v a0 = __builtin_amdgcn_cvt_pk_f32_fp8(qw[0], false), a1 = __builtin_amdgcn_cvt_pk_f32_fp8(qw[0], true), a2 = __builtin_amdgcn_cvt_pk_f32_fp8(qw[1], false), a3 = __builtin_amdgcn_cvt_pk_f32_fp8(qw[1], true);
      u32x4 pw; pw[0] = cvt_pk_bf16(a0[0], a0[1]); pw[1] = cvt_pk_bf16(a1[0], a1[1]); pw[2] = cvt_pk_bf16(a2[0], a2[1]); pw[3] = cvt_pk_bf16(a3[0], a3[1]);
      union { u32x4 u; bf16x8 v; } cv; cv.u = pw; qB[s] = cv.v; }
    epoch += 2u; pair_sync(pcnt, epoch, lane);
    u32x4 stg[8];
    const bf16_t* cbase = ckvn + (size_t)b * L * 256 + wch * 8;
#define P4_LOAD(ch) do { const u32x4 kk_ = *(const LAS u32x4*)(idxs + tok * 256 + (ch) * 32 + wrow); \
      _Pragma("unroll") for (int i = 0; i < 8; ++i) { \
      const int key = (int)((kk_[i >> 1] >> (16 * (i & 1))) & 0xffffu); stg[i] = *(const u32x4*)(cbase + (size_t)key * 256); } } while (0)
#define P4_WRITE(bufp) do { _Pragma("unroll") for (int i = 0; i < 8; ++i) \
      *(LAS u32x4*)((bufp) + (wrow + i) * CROW + 16 * (wch ^ (lane >> 5))) = stg[i]; } while (0)
    P4_LOAD(0);
    P4_WRITE(cbuf + tok * CTOK);
    if (nch > 1) P4_LOAD(1);
    float m_run = -1e30f, l_run = 0.f;
    f32x4 o[16];
#pragma unroll
    for (int ct = 0; ct < 16; ++ct) o[ct] = (f32x4){0.f, 0.f, 0.f, 0.f};
    epoch += 2u; pair_sync(pcnt, epoch, lane);
    for (int ch = 0; ch < nch; ++ch) {
      LAS unsigned char* cb = cbuf + (ch & 1) * CBUF + tok * CTOK;
      if (ch + 1 < nch) { P4_WRITE(cbuf + ((ch + 1) & 1) * CBUF + tok * CTOK); if (ch + 2 < nch) P4_LOAD(ch + 2); }
      f32x4 s0 = (f32x4){0.f, 0.f, 0.f, 0.f}, s1 = (f32x4){0.f, 0.f, 0.f, 0.f};
#pragma unroll
      for (int s = 0; s < 8; ++s) {
        const bf16x8 a0 = *(const LAS bf16x8*)(cb + r16 * CROW + s * 64 + qoff);
        const bf16x8 a1 = *(const LAS bf16x8*)(cb + (16 + r16) * CROW + s * 64 + qoff);
        s0 = __builtin_amdgcn_mfma_f32_16x16x32_bf16(a0, qB[s], s0, 0, 0, 0);
        s1 = __builtin_amdgcn_mfma_f32_16x16x32_bf16(a1, qB[s], s1, 0, 0, 0);
      }
      const int slotb = ch * 32 + 4 * g;
      const u32x2 k0 = *(const LAS u32x2*)(idxs + tok * 256 + slotb), k1 = *(const LAS u32x2*)(idxs + tok * 256 + slotb + 16);
      float lg0[4], lg1[4]; float mx = -1e30f;
      const bool full = (ch * 32 + 32 <= nk);
      int dd0[4], dd1[4]; int dmin = 1 << 20;
#pragma unroll
      for (int i = 0; i < 4; ++i) {
        const int key0 = (int)((k0[i >> 1] >> (16 * (i & 1))) & 0xffffu), key1 = (int)((k1[i >> 1] >> (16 * (i & 1))) & 0xffffu);
        dd0[i] = t - key0; dd1[i] = t - key1; dmin = min(dmin, min(dd0[i], dd1[i]));
      }
      if (__ballot(dmin < 128) == 0ull) {
        const float bfar = biasd[128 * 32 + head];
#pragma unroll
        for (int i = 0; i < 4; ++i) { lg0[i] = s0[i] * SC + bfar; lg1[i] = s1[i] * SC + bfar; }
      } else {
#pragma unroll
        for (int i = 0; i < 4; ++i) {
          const int d0 = min(max(dd0[i], 0), 128), d1 = min(max(dd1[i], 0), 128);
          lg0[i] = s0[i] * SC + biasd[d0 * 32 + head];
          lg1[i] = s1[i] * SC + biasd[d1 * 32 + head];
        }
      }
#pragma unroll
      for (int i = 0; i < 4; ++i) {
        if (!full) {
          lg0[i] = (slotb + i < nk) ? lg0[i] : -1e30f;
          lg1[i] = (slotb + 16 + i < nk) ? lg1[i] : -1e30f;
        }
        mx = vmax(mx, vmax(lg0[i], lg1[i]));
      }
      mx = pmax32(pmax16(mx));
      float alpha = 1.f;
      if (__ballot(mx > m_run + 8.f) != 0ull) {
        const float m_new = vmax(m_run, mx); alpha = __builtin_amdgcn_exp2f(m_run - m_new); m_run = m_new;
#pragma unroll
        for (int ct = 0; ct < 16; ++ct) o[ct] *= alpha;
      }
      float ps = 0.f; f32x4 p0, p1;
#pragma unroll
      for (int i = 0; i < 4; ++i) { p0[i] = __builtin_amdgcn_exp2f(lg0[i] - m_run); p1[i] = __builtin_amdgcn_exp2f(lg1[i] - m_run); ps += p0[i] + p1[i]; }
      l_run = l_run * alpha + ps;
      const u32x4 pw = pack8(p0, p1);
      bf16x8 pb; { union { u32x4 u; bf16x8 v; } cv; cv.u = pw; pb = cv.v; }
      LAS unsigned char* trb = cb + troff;
#pragma unroll
      for (int ct = 0; ct < 16; ++ct) {
        const s16x4 ta = __builtin_amdgcn_ds_read_tr16_b64_v4i16((LAS s16x4*)(trb + 32 * ct));
        const s16x4 tb = __builtin_amdgcn_ds_read_tr16_b64_v4i16((LAS s16x4*)(trb + 16 * CROW + 32 * ct));
        const bf16x8 a = {ta[0], ta[1], ta[2], ta[3], tb[0], tb[1], tb[2], tb[3]};
        o[ct] = __builtin_amdgcn_mfma_f32_16x16x32_bf16(a, pb, o[ct], 0, 0, 0);
      }
      epoch += 2u; pair_sync(pcnt, epoch, lane);
    }
    const float l = psum32(psum16(l_run));
    const float inv = 16.f / l;
    unsigned char* orow = qrow + 4 * g;
#pragma unroll
    for (int ct = 0; ct < 16; ++ct) {
      unsigned w = __builtin_amdgcn_cvt_pk_fp8_f32(o[ct][0] * inv, o[ct][1] * inv, 0, false); w = __builtin_amdgcn_cvt_pk_fp8_f32(o[ct][2] * inv, o[ct][3] * inv, w, true);
      if (!dry) *(unsigned*)(orow + 16 * ct) = w;
    }
#undef P4_LOAD
#undef P4_WRITE
  }
}

__device__ __forceinline__ void p8_pool(const Params& p, int bid, int nb) {
  const bf16_t* U = (const bf16_t*)(p.ws + OFF_RQ); const bf16_t* Z = (const bf16_t*)(p.ws + OFF_RZ); bf16_t* Y = (bf16_t*)p.out;
  int tid = threadIdx.x; asm volatile("" : "+v"(tid));
  const int n0 = tid * 8, w = 2 << (tid >> 7);
  float bg[8], scl[8];
#pragma unroll
  for (int j = 0; j < 8; ++j) { bg[j] = ((const float*)(p.ws + OFF_SMALL))[SM_BGRP + n0 + j]; scl[j] = ((const float*)(p.ws + OFF_SMALL))[SM_SCALE + n0 + j]; }
  for (int item = bid; item < T / 32; item += nb) {
    const int tg0 = item * 32, t0 = tg0 & 2047;
    const bf16_t* ub = U + (size_t)(tg0 - t0) * 4096 + n0;
    float sum[8];
#pragma unroll
    for (int j = 0; j < 8; ++j) sum[j] = 0.f;
    { u32x4 pv[15];
#pragma unroll
      for (int k = 1; k < 16; ++k) { const int s = t0 - k; pv[k - 1] = (k < w && s >= 0) ? *(const u32x4*)(ub + (size_t)s * 4096) : (u32x4){0u, 0u, 0u, 0u}; }
#pragma unroll
      for (int k = 0; k < 15; ++k)
#pragma unroll
        for (int j = 0; j < 4; ++j) { sum[2 * j] += bflo(pv[k][j]); sum[2 * j + 1] += bfhi(pv[k][j]); } }
    for (int tb = 0; tb < 32; tb += 4) {
      u32x4 cv[4], zv[4], ov[4];
#pragma unroll
      for (int k = 0; k < 4; ++k) {
        const int t = t0 + tb + k;
        cv[k] = *(const u32x4*)(ub + (size_t)t * 4096);
        zv[k] = *(const u32x4*)(Z + (size_t)(tg0 + tb + k) * 4096 + n0);
        ov[k] = (t - w + 1 >= 0) ? *(const u32x4*)(ub + (size_t)(t - w + 1) * 4096) : (u32x4){0u, 0u, 0u, 0u};
      }
#pragma unroll
      for (int k = 0; k < 4; ++k) {
        const int t = t0 + tb + k;
        float cur[8], zf[8], y[8];
#pragma unroll
        for (int j = 0; j < 4; ++j) { cur[2 * j] = bflo(cv[k][j]); cur[2 * j + 1] = bfhi(cv[k][j]); zf[2 * j] = bflo(zv[k][j]); zf[2 * j + 1] = bfhi(zv[k][j]); }
        const float icnt = __builtin_amdgcn_rcpf((float)min(w, t + 1));
#pragma unroll
        for (int j = 0; j < 8; ++j) { sum[j] += cur[j]; y[j] = ((sum[j] * icnt - cur[j]) + bg[j]) * scl[j] * silu_fast(zf[j]); }
        u32x4 o; o[0] = cvt_pk_bf16(y[0], y[1]); o[1] = cvt_pk_bf16(y[2], y[3]); o[2] = cvt_pk_bf16(y[4], y[5]); o[3] = cvt_pk_bf16(y[6], y[7]);
        *(u32x4*)(Y + (size_t)(tg0 + tb + k) * 4096 + n0) = o;
#pragma unroll
        for (int j = 0; j < 4; ++j) { sum[2 * j] -= bflo(ov[k][j]); sum[2 * j + 1] -= bfhi(ov[k][j]); }
        asm volatile("" ::: "memory");
      }
    }
  }
}

__device__ __forceinline__ void p10_final(const Params& p, int bid, int nb) {
  int tid = threadIdx.x; asm volatile("" : "+v"(tid));
  const int lane = tid & 63, wid = tid >> 6;
  const float* ss2 = (const float*)(p.ws + OFF_SS) + 2 * T;
  const bf16_t* h2 = (const bf16_t*)(p.ws + OFF_RQ);
  f32x4 g[8];
#pragma unroll
  for (int j = 0; j < 8; ++j) g[j] = *(const f32x4*)((const float*)(p.ws + OFF_SMALL) + SM_FINAL + (lane + 64 * j) * 4);
  for (int row = bid * 8 + wid; row < T; row += nb * 8) {
    const float r = rsqrtf(ss2[row] * (1.f / 2048.f) + EPS);
    f32x4* ptr = (f32x4*)(p.out + (size_t)row * D);
    u32x2 hv[8];
#pragma unroll
    for (int j = 0; j < 8; ++j) hv[j] = *(const u32x2*)(h2 + (size_t)row * D + (lane + 64 * j) * 4);
#pragma unroll
    for (int j = 0; j < 8; ++j) { const f32x4 v = {bflo(hv[j][0]), bfhi(hv[j][0]), bflo(hv[j][1]), bfhi(hv[j][1])}; ptr[lane + 64 * j] = v * r * g[j]; }
  }
}

__device__ __forceinline__ void grid_bar(unsigned* ctr, unsigned target) {
  __syncthreads();
  if (threadIdx.x == 0) {
    __builtin_amdgcn_fence(__ATOMIC_RELEASE, "agent");
    asm volatile("s_waitcnt vmcnt(0)" ::: "memory");
    __hip_atomic_fetch_add(ctr, 1u, __ATOMIC_RELAXED, __HIP_MEMORY_SCOPE_AGENT);
    while (__hip_atomic_load(ctr, __ATOMIC_RELAXED, __HIP_MEMORY_SCOPE_AGENT) < target) __builtin_amdgcn_s_sleep(2);
    __builtin_amdgcn_fence(__ATOMIC_ACQUIRE, "agent");
    asm volatile("s_waitcnt vmcnt(0)" ::: "memory");
  }
  __syncthreads();
}

__global__ void __launch_bounds__(512, 2) fwd_mega(Params p) {
  extern __shared__ __attribute__((aligned(16))) unsigned char lds[];
  cg::grid_group grid = cg::this_grid();
  const int bid = blockIdx.x, nb = gridDim.x;
  unsigned char* ws = p.ws;
  LAS unsigned char* gl = (LAS unsigned char*)lds;
  float* ss = (float*)(ws + OFF_SS);
  unsigned* bar = (unsigned*)(ws + OFF_BAR);

#define REPS(k)
#define DRY false
  if (bid == 0 && threadIdx.x == 0) __hip_atomic_store(bar, 0u, __ATOMIC_RELAXED, __HIP_MEMORY_SCOPE_AGENT);
  REPS(0) { p0_prep(p, lds, bid, nb); __syncthreads(); }
  grid.sync();

  REPS(1) {
    g8::Sched S; S.init(16, 8, nb, (bid + (nb >> 1)) % nb); S.A0 = (const char*)(ws + OFF_WG); S.sAm = (size_t)256 * 1024 * 2; S.B0 = (const char*)(ws + OFF_WU); S.sBn = (size_t)256 * 1024 * 2; S.sBg = (size_t)2048 * 1024 * 2; S.gshift = 2;
    g8::EpiBf16 E{(bf16_t*)(ws + OFF_WB), nullptr, 1 << 30, LDWB, nullptr};
    g8::gemm_phase(gl, 1024, 1024, 1024, S, E);
  }
  REPS(2) {
    { g8::Sched S; S.init(128, 32, nb, bid); S.A0 = (const char*)(ws + OFF_XQ); S.sAm = (size_t)256 * 2048; S.B0 = (const char*)(ws + OFF_WA); S.sBn = (size_t)256 * 2048;
      g8::EpiProjA E{ss, (bf16_t*)(ws + OFF_RQ), (bf16_t*)(ws + OFF_RZ), (float*)(ws + OFF_CKVR), (bf16_t*)(ws + OFF_QIDX), (bf16_t*)(ws + OFF_KIDX), (float*)(ws + OFF_WIDX), (const float*)(ws + OFF_SMALL) + SM_KIDXN, 0, 1.f / 64.f};
      g8::gemm_phase<g8::EpiProjA, true>(gl, 1024, 1024, 1024, S, E); }
    { g8::Sched S; S.init(128, 6, nb, bid); S.A0 = (const char*)(ws + OFF_QL0); S.sAm = (size_t)256 * 2048 * 2; S.B0 = (const char*)(ws + OFF_WAI); S.sBn = (size_t)256 * 2048 * 2;
      g8::EpiProjA E{ss, (bf16_t*)(ws + OFF_RQ), (bf16_t*)(ws + OFF_RZ), (float*)(ws + OFF_CKVR), (bf16_t*)(ws + OFF_QIDX), (bf16_t*)(ws + OFF_KIDX), (float*)(ws + OFF_WIDX), (const float*)(ws + OFF_SMALL) + SM_KIDXN, 32, 1.f};
      g8::gemm_phase(gl, 2048, 2048, 2048, S, E); }
  }
  grid_bar(bar, (unsigned)(1 * nb));

  REPS(3) { p3_indexer(p, lds, bid, nb, 1, 1); __syncthreads(); }
  REPS(11) { p3_ckvnorm(p, bid, nb); }
  __syncthreads();
  REPS(12) {
    g8::Sched S; S.init(128, 32, nb, bid); S.A0 = (const char*)(ws + OFF_RQ); S.sAm = (size_t)256 * 4096; S.sAn = 256; S.anshift = 1; S.B0 = (const char*)(ws + OFF_WUK); S.sBn = (size_t)256 * 256;
    g8::EpiQlat E{ws + OFF_QL0, 1.f / 16.f};
    g8::gemm_phase<g8::EpiQlat, true, 2>(gl, 128, 2048, 128, S, E);
  }
  grid_bar(bar, (unsigned)(2 * nb));

  REPS(4) { p4_attn(p, lds, bid, nb, DRY); __syncthreads(); }
  grid_bar(bar, (unsigned)(3 * nb));

  REPS(5) {
    g8::Sched S; S.init(128, 16, nb, bid); S.A0 = (const char*)(ws + OFF_QL0); S.sAm = (size_t)256 * 8192; S.sAn = 512; S.B0 = (const char*)(ws + OFF_WUV); S.sBn = (size_t)256 * 512;
    g8::EpiGate E{ws + OFF_RQ, ws + OFF_RZ, 16.f / 256.f};
    g8::gemm_phase<g8::EpiGate, true, 1>(gl, 256, 4096, 256, S, E);
  }
  grid_bar(bar, (unsigned)(4 * nb));

  REPS(6) {
    g8::Sched S; S.init(128, 8, nb, bid); S.A0 = (const char*)(ws + OFF_RQ); S.sAm = (size_t)256 * 4096; S.B0 = (const char*)(ws + OFF_WOUTA); S.sBn = (size_t)256 * 4096;
    g8::EpiRes E{p.x, nullptr, 0, nullptr, (bf16_t*)(ws + OFF_QL0), LDH, ss + T, 1.f / 1024.f};
    g8::gemm_phase<g8::EpiRes, true>(gl, 2048, 2048, 2048, S, E);
  }
  grid_bar(bar, (unsigned)(5 * nb));

  REPS(7) {
    g8::Sched S; S.init(128, 32, nb, bid); S.A0 = (const char*)(ws + OFF_QL0); S.sAm = (size_t)256 * LDH * 2; S.B0 = (const char*)(ws + OFF_WB); S.sBn = (size_t)256 * LDWB * 2;
    g8::EpiBf16 E{(bf16_t*)(ws + OFF_RQ), (bf16_t*)(ws + OFF_RZ), 16, 4096, ss + T};
    g8::gemm_phase(gl, 2048, LDH, LDWB, S, E);
  }
  grid_bar(bar, (unsigned)(6 * nb));

  REPS(8) { p8_pool(p, bid, nb); }
  grid_bar(bar, (unsigned)(7 * nb));

  REPS(9) {
    g8::Sched S; S.init(128, 8, nb, bid); S.A0 = (const char*)p.out; S.sAm = (size_t)256 * 4096 * 2; S.B0 = (const char*)(ws + OFF_WOUTB); S.sBn = (size_t)256 * 4096 * 2;
    g8::EpiRes E{nullptr, (const bf16_t*)(ws + OFF_QL0), LDH, nullptr, (bf16_t*)(ws + OFF_RQ), 2048, ss + 2 * T, 1.f};
    g8::gemm_phase(gl, 4096, 4096, 4096, S, E);
  }
  grid_bar(bar, (unsigned)(8 * nb));

  p10_final(p, bid, nb);
}

extern "C" void kernel_launch(void* const* d_in, const int* in_sizes, int n_in,
                              void* d_out, int out_size, void* d_ws, size_t ws_size,
                              hipStream_t stream) {
  static int grid_blocks = 0;
  if (!grid_blocks) {
    int dev = 0, cus = 0, per_cu = 0;
    (void)hipGetDevice(&dev);
    (void)hipDeviceGetAttribute(&cus, hipDeviceAttributeMultiprocessorCount, dev);
    (void)hipFuncSetAttribute((const void*)fwd_mega, hipFuncAttributeMaxDynamicSharedMemorySize, LDS_BYTES);
    (void)hipOccupancyMaxActiveBlocksPerMultiprocessor(&per_cu, (const void*)fwd_mega, 512, LDS_BYTES);
    if (per_cu < 1) per_cu = 1;
    grid_blocks = cus * per_cu;
    if (ws_size < WS_END) fprintf(stderr, "kernel_launch: workspace too small: %zu < %zu\n", ws_size, (size_t)WS_END);
  }
  Params p{};
  p.x = (const float*)d_in[0]; p.norm_a = (const float*)d_in[1]; p.w_in_a = (const float*)d_in[2]; p.kv_norm = (const float*)d_in[3];
  p.kidx_norm = (const float*)d_in[4]; p.w_uk = (const float*)d_in[5]; p.w_uv = (const float*)d_in[6]; p.w_out_a = (const float*)d_in[7];
  p.norm_b = (const float*)d_in[8]; p.w_in_b = (const float*)d_in[9]; p.w_grp = (const float*)d_in[10]; p.b_grp = (const float*)d_in[11];
  p.scale_b = (const float*)d_in[12]; p.w_out_b = (const float*)d_in[13]; p.rel_bias = (const float*)d_in[14]; p.final_norm = (const float*)d_in[15];
  p.out = (float*)d_out; p.ws = (unsigned char*)d_ws; p.probe = PROBE_PHASE; p.pad = 0;
  void* args[] = {&p};
  hipError_t e = hipLaunchCooperativeKernel((void*)fwd_mega, dim3(grid_blocks), dim3(512), args, LDS_BYTES, stream);
  if (e != hipSuccess) fprintf(stderr, "cooperative launch failed: %s (grid %d)\n", hipGetErrorString(e), grid_blocks);
}
```

```cpp
#include <hip/hip_runtime.h>
#include <hip/hip_cooperative_groups.h>
#include <cstdio>
#include <cstdint>
namespace cg = cooperative_groups;

#define LAS __attribute__((address_space(3)))
typedef unsigned short bf16_t;
typedef short bf16x8 __attribute__((ext_vector_type(8)));
typedef short s16x4 __attribute__((ext_vector_type(4)));
typedef float f32x4 __attribute__((ext_vector_type(4)));
typedef float f32x16 __attribute__((ext_vector_type(16)));
typedef unsigned u32x4 __attribute__((ext_vector_type(4)));
typedef unsigned u32x2 __attribute__((ext_vector_type(2)));

constexpr int T = 32768, L = 2048, D = 2048, DI = 4096;
constexpr float EPS = 1e-6f;
constexpr float LOG2E = 1.4426950408889634f;
constexpr int LDS_BYTES = 156 * 1024;
#ifndef PROBE_PHASE
#define PROBE_PHASE -1
#endif

constexpr size_t OFF_RQ = 0;
constexpr size_t OFF_RZ = 268435456;
constexpr size_t OFF_QL0 = 536870912;
constexpr size_t OFF_XQ = OFF_QL0 + 134217728;
constexpr size_t OFF_WOUTA = 805306368;
constexpr size_t OFF_WB = OFF_WOUTA + 16777216;
constexpr int LDH = 2112, LDWB = 2112;
constexpr size_t OFF_WU = OFF_WB + (size_t)8192 * LDWB * 2;
constexpr size_t OFF_WG = OFF_WU + 16777216;
constexpr size_t OFF_WOUTB = OFF_WG + 8388608;
constexpr size_t OFF_WUK = OFF_WOUTB + 16777216;
constexpr size_t OFF_WUV = OFF_WUK + 2097152;
constexpr size_t OFF_WA = OFF_WUV + 4194304;
constexpr size_t OFF_WAI = OFF_WA + (size_t)8192 * 2048;
constexpr size_t OFF_IDX = OFF_WA;
constexpr size_t OFF_CKVN = OFF_WA + 16777216;
constexpr size_t OFF_CKVR = OFF_WA + 39845888;
constexpr size_t OFF_QIDX = OFF_CKVR + 33554432;
constexpr size_t OFF_KIDX = OFF_QIDX + 67108864;
constexpr size_t OFF_WIDX = OFF_KIDX + 4194304;
constexpr size_t OFF_SS = OFF_WIDX + 2097152;
constexpr size_t OFF_BAR = OFF_SS + 3 * 131072;
constexpr size_t OFF_SMALL = OFF_BAR + 256;
constexpr int SM_KIDXN = 0, SM_KVN = 64, SM_RELB = 320, SM_BGRP = 1344, SM_SCALE = 5440, SM_FINAL = 9536, SM_TOTAL = 11584;
constexpr size_t WS_END = OFF_SMALL + (size_t)SM_TOTAL * 4;

struct Params {
  const float *x, *norm_a, *w_in_a, *kv_norm, *kidx_norm, *w_uk, *w_uv, *w_out_a, *norm_b, *w_in_b, *w_grp, *b_grp, *scale_b, *w_out_b, *rel_bias, *final_norm;
  float* out; unsigned char* ws; int probe; int pad;
};

__device__ __forceinline__ unsigned cvt_pk_bf16(float lo, float hi) { unsigned r; asm("v_cvt_pk_bf16_f32 %0, %1, %2" : "=v"(r) : "v"(lo), "v"(hi)); return r; }
__device__ __forceinline__ float bf2f(unsigned short b) { return __uint_as_float(((unsigned)b) << 16); }
__device__ __forceinline__ float bflo(unsigned w) { return __uint_as_float(w << 16); }
__device__ __forceinline__ float bfhi(unsigned w) { return __uint_as_float(w & 0xffff0000u); }
__device__ __forceinline__ u32x4 pack8(f32x4 a, f32x4 b) { u32x4 w; w[0] = cvt_pk_bf16(a[0], a[1]); w[1] = cvt_pk_bf16(a[2], a[3]); w[2] = cvt_pk_bf16(b[0], b[1]); w[3] = cvt_pk_bf16(b[2], b[3]); return w; }
__device__ __forceinline__ float sx(float v, int mask, int lane) { return __int_as_float(__builtin_amdgcn_ds_bpermute((lane ^ mask) << 2, __float_as_int(v))); }
typedef unsigned u32x2s __attribute__((ext_vector_type(2)));
__device__ __forceinline__ float pmax16(float x) { const u32x2s r = __builtin_amdgcn_permlane16_swap(__float_as_uint(x), __float_as_uint(x), false, false); return __builtin_amdgcn_fmed3f(__uint_as_float(r[0]), __uint_as_float(r[1]), __builtin_inff()); }
__device__ __forceinline__ float pmax32(float x) { const u32x2s r = __builtin_amdgcn_permlane32_swap(__float_as_uint(x), __float_as_uint(x), false, false); return __builtin_amdgcn_fmed3f(__uint_as_float(r[0]), __uint_as_float(r[1]), __builtin_inff()); }
__device__ __forceinline__ float psum16(float x) { const u32x2s r = __builtin_amdgcn_permlane16_swap(__float_as_uint(x), __float_as_uint(x), false, false); return __uint_as_float(r[0]) + __uint_as_float(r[1]); }
__device__ __forceinline__ float psum32(float x) { const u32x2s r = __builtin_amdgcn_permlane32_swap(__float_as_uint(x), __float_as_uint(x), false, false); return __uint_as_float(r[0]) + __uint_as_float(r[1]); }
template <int CTRL> __device__ __forceinline__ float dppf(float x) { return __int_as_float(__builtin_amdgcn_update_dpp(0, __float_as_int(x), CTRL, 0xf, 0xf, false)); }
__device__ __forceinline__ float vmin(float a, float b) { return __builtin_amdgcn_fmed3f(a, b, -__builtin_inff()); }
__device__ __forceinline__ float pmin16(float x) { const u32x2s r = __builtin_amdgcn_permlane16_swap(__float_as_uint(x), __float_as_uint(x), false, false); return vmin(__uint_as_float(r[0]), __uint_as_float(r[1])); }
__device__ __forceinline__ float pmin32(float x) { const u32x2s r = __builtin_amdgcn_permlane32_swap(__float_as_uint(x), __float_as_uint(x), false, false); return vmin(__uint_as_float(r[0]), __uint_as_float(r[1])); }
__device__ __forceinline__ float wave_sum(float s, int) { s += dppf<0x128>(s); s += dppf<0x124>(s); s += dppf<0x122>(s); s += dppf<0x121>(s); return psum32(psum16(s)); }
__device__ __forceinline__ float wave_max(float s) { s = __builtin_amdgcn_fmed3f(s, dppf<0x128>(s), __builtin_inff()); s = __builtin_amdgcn_fmed3f(s, dppf<0x124>(s), __builtin_inff()); s = __builtin_amdgcn_fmed3f(s, dppf<0x122>(s), __builtin_inff()); s = __builtin_amdgcn_fmed3f(s, dppf<0x121>(s), __builtin_inff()); return pmax32(pmax16(s)); }
__device__ __forceinline__ float wave_min(float s) { s = vmin(s, dppf<0x128>(s)); s = vmin(s, dppf<0x124>(s)); s = vmin(s, dppf<0x122>(s)); s = vmin(s, dppf<0x121>(s)); return pmin32(pmin16(s)); }
__device__ __forceinline__ float vmax(float a, float b) { return __builtin_amdgcn_fmed3f(a, b, __builtin_inff()); }
__device__ __forceinline__ float relu_i(float x) { return __int_as_float(max(__float_as_int(x), 0)); }
__device__ __forceinline__ float silu(float z) { return z / (1.f + __expf(-z)); }
__device__ __forceinline__ float silu_fast(float z) { return z * __builtin_amdgcn_rcpf(1.f + __builtin_amdgcn_exp2f(-1.4426950408889634f * z)); }

namespace g8 {
constexpr int BM = 256, BK = 64, HALF = 128, HTB = HALF * BK * 2, STAGE_BYTES = 8 * HTB, NXCD = 8, WGM = 2;
__device__ __forceinline__ int lds_byte(int r, int c) { const int st = (r >> 4) * 2 + (c >> 5), rr = r & 15, cc = c & 31, ob = rr * 64 + cc * 2; return st * 1024 + (ob ^ (((ob >> 9) & 1) << 5)); }
__device__ __forceinline__ void stage_rc(int b, int& R, int& C) { const int st = b / 1024, sb = b % 1024, swz = sb ^ (((sb >> 9) & 1) << 5); R = (st >> 1) * 16 + swz / 64; C = (st & 1) * 32 + (swz % 64) / 2; }
__device__ __forceinline__ int perm32(int rho) { const int n = rho >> 4, i = rho & 15; return 8 * (i >> 2) + 4 * n + (i & 3); }

struct GUnit { const char* A; const char* B; int pm, pn; };

struct Sched {
  int nM, nN, nwg, G, c;
  const char* A0; const char* A1; int pmSplit; size_t sAm, sAn;
  const char* B0; size_t sBn, sBg; int gshift; int anshift;
  __device__ __forceinline__ void init(int nM_, int nN_, int G_, int c_) { nM = nM_; nN = nN_; nwg = nM * nN; G = G_; c = c_; A1 = nullptr; pmSplit = 1 << 30; sAn = 0; sBg = 0; gshift = 0; anshift = 0; }
  __device__ __forceinline__ bool next(int i, GUnit& u) const {
    const int Lx = i * G + c; if (Lx >= nwg) return false;
    int wgid = Lx; { const int q = nwg / NXCD, r = nwg % NXCD, xcd = wgid % NXCD, off = wgid / NXCD; wgid = (xcd < r ? xcd * (q + 1) : r * (q + 1) + (xcd - r) * q) + off; }
    const int nig = WGM * nN, gid = wgid / nig, fm = gid * WGM, gsz = (nM - fm) < WGM ? (nM - fm) : WGM;
    u.pm = fm + ((wgid % nig) % gsz); u.pn = (wgid % nig) / gsz;
    u.A = (u.pm < pmSplit ? A0 + (size_t)u.pm * sAm : A1 + (size_t)(u.pm - pmSplit) * sAm) + (size_t)(u.pn >> anshift) * sAn;
    u.B = B0 + (size_t)u.pn * sBn + (size_t)(u.pm >> gshift) * sBg;
    return true;
  }
};

typedef int v8i __attribute__((ext_vector_type(8)));
__device__ __forceinline__ v8i cat8(bf16x8 a, bf16x8 b) { union { bf16x8 h[2]; v8i v; } u; u.h[0] = a; u.h[1] = b; return u.v; }
template <class Epi, bool FP8 = false, int BD = 0>
__device__ __forceinline__ void gemm_phase(LAS unsigned char* lds, const int K, const int lda, const int ldb, const Sched& S, const Epi& E) {
  int tid = threadIdx.x; asm volatile("" : "+v"(tid));
  const int wid = __builtin_amdgcn_readfirstlane(tid >> 6), lane = tid & 63, wr = wid >> 2, wc = wid & 3, fr = lane & 15, fq = lane >> 4;
  const int nt = K / BK;
  unsigned voffA, voffB;
  { int R, C; stage_rc(tid * 16, R, C); const int Rb = (R & ~31) + perm32(R & 31); voffA = (unsigned)(R * lda + C) * 2u; voffB = (unsigned)(Rb * ldb + C) * 2u; }
  const size_t p2A = (size_t)64 * lda * 2, p2B = (size_t)64 * ldb * 2;
  const size_t kstep = (size_t)(BK * 2);
  const size_t hstepA = (size_t)HALF * lda * 2, hstepB = (size_t)HALF * ldb * 2;
  const unsigned ldsw = (unsigned)wid * 1024u;
  const int aoff = lds_byte(wr * 64 + fr, fq * 8), boff = lds_byte(wc * 32 + fr, fq * 8);
#define G8_SA(b, h) (((b) * 2 + (h)) * HTB)
#define G8_SB(b, h) ((4 + (b) * 2 + (h)) * HTB)
#define G8_STAGE(bufoff, gbase, NM) do { _Pragma("unroll") for (int _i = 0; _i < 2; ++_i) { \
    const char* _b = (const char*)(gbase) + (_i ? p2##NM : (size_t)0); asm volatile("" : "+s"(_b));     \
    __builtin_amdgcn_global_load_lds((const unsigned*)(_b + voff##NM), (LAS unsigned*)(lds + (bufoff) + ldsw + _i * 8192), 16, 0, 0); } } while (0)
#define G8_LDA(dst, b, h) do { _Pragma("unroll") for (int m = 0; m < 4; ++m) { \
    if constexpr (FP8) dst##8[m] = cat8(*(const LAS bf16x8*)(lds + G8_SA(b, h) + aoff + m * 2048), *(const LAS bf16x8*)(lds + G8_SA(b, h) + aoff + m * 2048 + 1024)); \
    else { _Pragma("unroll") for (int k = 0; k < 2; ++k) dst[m][k] = *(const LAS bf16x8*)(lds + G8_SA(b, h) + aoff + m * 2048 + k * 1024); } } } while (0)
#define G8_LDB(dst, b, h) do { _Pragma("unroll") for (int n = 0; n < 2; ++n) { \
    if constexpr (FP8) dst##8[n] = cat8(*(const LAS bf16x8*)(lds + G8_SB(b, h) + boff + n * 2048), *(const LAS bf16x8*)(lds + G8_SB(b, h) + boff + n * 2048 + 1024)); \
    else { _Pragma("unroll") for (int k = 0; k < 2; ++k) dst[n][k] = *(const LAS bf16x8*)(lds + G8_SB(b, h) + boff + n * 2048 + k * 1024); } } } while (0)
#define G8_MMA(ai, bj, At, Bt) do { __builtin_amdgcn_s_setprio(1); _Pragma("unroll") for (int m = 0; m < 4; ++m) _Pragma("unroll") for (int n = 0; n < 2; ++n) { \
    if constexpr (FP8) acc[ai][bj][m][n] = __builtin_amdgcn_mfma_scale_f32_16x16x128_f8f6f4(Bt##8[n], At##8[m], acc[ai][bj][m][n], 0, 0, 0, 0, 0, 0); \
    else { _Pragma("unroll") for (int k = 0; k < 2; ++k) acc[ai][bj][m][n] = __builtin_amdgcn_mfma_f32_16x16x32_bf16(Bt[n][k], At[m][k], acc[ai][bj][m][n], 0, 0, 0); } } \
    __builtin_amdgcn_s_setprio(0); } while (0)
#define G8_WAIT_V(n) asm volatile("s_waitcnt vmcnt(" #n ")" ::: "memory")
#define G8_WAIT_L(n) asm volatile("s_waitcnt lgkmcnt(" #n ")" ::: "memory")
#define G8_BAR __builtin_amdgcn_s_barrier()
#define G8_SCHED __builtin_amdgcn_sched_barrier(0)
  GUnit cur, nxt; int ui = 0;
  if (!S.next(0, cur)) return;
  f32x4 acc[2][2][4][2];
#pragma unroll
  for (int a = 0; a < 2; ++a)
#pragma unroll
    for (int b = 0; b < 2; ++b)
#pragma unroll
      for (int m = 0; m < 4; ++m)
#pragma unroll
        for (int n = 0; n < 2; ++n) acc[a][b][m][n] = (f32x4){0.f, 0.f, 0.f, 0.f};
  bf16x8 At[4][2], B0[2][2], B1[2][2];
  v8i At8[4], B08[2], B18[2];
  const char* cA = cur.A; const char* cB = cur.B;
  G8_STAGE(G8_SB(0, 0), cB, B); G8_STAGE(G8_SB(0, 1), cB + hstepB, B); G8_STAGE(G8_SA(0, 0), cA, A); G8_STAGE(G8_SA(0, 1), cA + hstepA, A);
  if (wr == 1) G8_BAR;
  G8_WAIT_V(2); G8_BAR;
  G8_STAGE(G8_SB(1, 0), cB + kstep, B); G8_STAGE(G8_SA(1, 0), cA + kstep, A); G8_STAGE(G8_SB(1, 1), cB + hstepB + kstep, B);
  G8_WAIT_V(6); G8_BAR;
  for (;;) {
    const bool has_next = S.next(ui + 1, nxt);
    const char* nA = has_next ? nxt.A : cA; const char* nB = has_next ? nxt.B : cB;
    for (int t = 0; t < nt; t += 2) {
      const bool last = (t == nt - 2);
      const char* a1 = cA + (size_t)(t + 1) * kstep + hstepA;
      const char* a2 = last ? nA : cA + (size_t)(t + 2) * kstep; const char* b2 = last ? nB : cB + (size_t)(t + 2) * kstep;
      const char* a3 = a2 + kstep; const char* b3 = b2 + kstep;
      asm volatile("" : "+s"(a1), "+s"(a2), "+s"(b2), "+s"(a3), "+s"(b3));
      G8_LDB(B0, 0, 0); G8_LDB(B1, 0, 1); G8_SCHED; G8_LDA(At, 0, 0); G8_STAGE(G8_SA(1, 1), a1, A);
      const bool d0a = (BD == 0) || (BD == 1 && t < (nt >> 1)) || (BD == 2 && !(cur.pn & 1));
      const bool d1a = (BD == 0) || (BD == 1 && t >= (nt >> 1)) || (BD == 2 && !(cur.pn & 1));
      const bool d0b = (BD == 0) || (BD == 1 && t < (nt >> 1)) || (BD == 2 && (cur.pn & 1));
      const bool d1b = (BD == 0) || (BD == 1 && t >= (nt >> 1)) || (BD == 2 && (cur.pn & 1));
      G8_WAIT_V(8); G8_WAIT_L(0); G8_BAR; if (d0a) G8_MMA(0, 0, At, B0); if (d1a) G8_MMA(0, 1, At, B1); G8_BAR; G8_SCHED;
      G8_LDA(At, 0, 1); G8_STAGE(G8_SB(0, 0), b2, B); G8_STAGE(G8_SB(0, 1), b2 + hstepB, B); G8_STAGE(G8_SA(0, 0), a2, A);
      G8_WAIT_V(8); G8_WAIT_L(0); G8_BAR; if (d0a) G8_MMA(1, 0, At, B0); if (d1a) G8_MMA(1, 1, At, B1); G8_BAR; G8_SCHED;
      G8_LDB(B0, 1, 0); G8_LDB(B1, 1, 1); G8_SCHED; G8_LDA(At, 1, 0); G8_STAGE(G8_SA(0, 1), a2 + hstepA, A);
      G8_WAIT_V(8); G8_WAIT_L(0); G8_BAR; if (d0b) G8_MMA(0, 0, At, B0); if (d1b) G8_MMA(0, 1, At, B1); G8_BAR; G8_SCHED;
      G8_LDA(At, 1, 1); G8_STAGE(G8_SB(1, 0), b3, B); G8_STAGE(G8_SB(1, 1), b3 + hstepB, B); G8_STAGE(G8_SA(1, 0), a3, A);
      G8_WAIT_V(8); G8_WAIT_L(0); G8_BAR; if (d0b) G8_MMA(1, 0, At, B0); if (d1b) G8_MMA(1, 1, At, B1); G8_BAR; G8_SCHED;
    }
    if (wr == 0) G8_BAR;
    {
      int t2 = threadIdx.x; asm volatile("" : "+v"(t2));
      const int w2 = __builtin_amdgcn_readfirstlane(t2 >> 6), l2 = t2 & 63;
      E(acc, cur, w2 >> 2, w2 & 3, l2 & 15, l2 >> 4); }
    if (!has_next) break;
#pragma unroll
    for (int a = 0; a < 2; ++a)
#pragma unroll
      for (int b = 0; b < 2; ++b)
#pragma unroll
        for (int m = 0; m < 4; ++m)
#pragma unroll
          for (int n = 0; n < 2; ++n) acc[a][b][m][n] = (f32x4){0.f, 0.f, 0.f, 0.f};
    cur = nxt; cA = nA; cB = nB; ++ui;
    if (wr == 1) G8_BAR;
  }
  G8_WAIT_V(0);
  G8_BAR;
#undef G8_SA
#undef G8_SB
#undef G8_STAGE
#undef G8_LDA
#undef G8_LDB
#undef G8_MMA
#undef G8_WAIT_V
#undef G8_WAIT_L
#undef G8_BAR
#undef G8_SCHED
}

typedef f32x4 Acc[2][2][4][2];

struct EpiProjA {
  const float* ss0; bf16_t* q; bf16_t* z; float* ckv; bf16_t* qidx; bf16_t* kidx; float* widx; const float* kg; int pnoff; float osc;
  __device__ __forceinline__ void operator()(const Acc& acc, const GUnit& u, int wr, int wc, int fr, int fq) const {
    const int row0 = u.pm * 256 + wr * 64 + fr, pn = u.pn + pnoff;
#pragma unroll
    for (int ai = 0; ai < 2; ++ai)
#pragma unroll
      for (int m = 0; m < 4; ++m) {
        const int row = row0 + ai * 128 + m * 16;
        const float rs = rsqrtf(ss0[row] * (1.f / 2048.f) + EPS) * osc;
        if (pn < 32) {
          unsigned char* base = (unsigned char*)(pn < 16 ? q : z) + (size_t)row * 4096 + (pn & 15) * 256 + wc * 32 + 8 * fq;
#pragma unroll
          for (int bj = 0; bj < 2; ++bj) { const f32x4 a = acc[ai][bj][m][0] * rs, b = acc[ai][bj][m][1] * rs; u32x2 w;
            w[0] = __builtin_amdgcn_cvt_pk_fp8_f32(a[0], a[1], 0, false); w[0] = __builtin_amdgcn_cvt_pk_fp8_f32(a[2], a[3], w[0], true);
            w[1] = __builtin_amdgcn_cvt_pk_fp8_f32(b[0], b[1], 0, false); w[1] = __builtin_amdgcn_cvt_pk_fp8_f32(b[2], b[3], w[1], true);
            *(u32x2*)(base + bj * 128) = w; }
        } else if (pn == 32) {
          float* base = ckv + (size_t)row * 256 + wc * 32 + 8 * fq;
#pragma unroll
          for (int bj = 0; bj < 2; ++bj) { *(f32x4*)(base + bj * 128) = acc[ai][bj][m][0] * rs; *(f32x4*)(base + bj * 128 + 4) = acc[ai][bj][m][1] * rs; }
        } else if (pn < 37) {
          bf16_t* base = qidx + (size_t)row * 1024 + (pn - 33) * 256 + wc * 32 + 8 * fq;
#pragma unroll
          for (int bj = 0; bj < 2; ++bj) *(u32x4*)(base + bj * 128) = pack8(acc[ai][bj][m][0] * rs, acc[ai][bj][m][1] * rs);
        } else {
          if (wc == 0) {
            f32x4 v[2][2]; float s = 0.f;
#pragma unroll
            for (int bj = 0; bj < 2; ++bj)
#pragma unroll
              for (int n = 0; n < 2; ++n) { v[bj][n] = acc[ai][bj][m][n] * rs; s += v[bj][n][0] * v[bj][n][0] + v[bj][n][1] * v[bj][n][1] + v[bj][n][2] * v[bj][n][2] + v[bj][n][3] * v[bj][n][3]; }
            s = psum32(psum16(s));
            const float kr = rsqrtf(s * (1.f / 64.f) + EPS);
#pragma unroll
            for (int bj = 0; bj < 2; ++bj) {
              const f32x4 g0 = *(const f32x4*)(kg + 32 * bj + 8 * fq), g1 = *(const f32x4*)(kg + 32 * bj + 8 * fq + 4);
              *(u32x4*)(kidx + ((size_t)(row >> 5) * 4 + 2 * bj + (fq >> 1)) * 512 + ((fq & 1) * 32 + (row & 31)) * 8) = pack8(v[bj][0] * kr * g0, v[bj][1] * kr * g1);
            }
          } else if (wc == 1 && fq < 2) {
            float* base = widx + (size_t)row * 16 + 8 * fq;
            *(f32x4*)(base) = acc[ai][0][m][0] * (rs * 0.25f); *(f32x4*)(base + 4) = acc[ai][0][m][1] * (rs * 0.25f);
          }
        }
      }
  }
};

struct EpiBf16 {
  bf16_t* O0; bf16_t* O1; int nsplit; int ld; const float* ss;
  __device__ __forceinline__ void operator()(const Acc& acc, const GUnit& u, int wr, int wc, int fr, int fq) const {
    const int row0 = u.pm * 256 + wr * 64 + fr;
    bf16_t* ob = (u.pn < nsplit ? O0 + (size_t)u.pn * 256 : O1 + (size_t)(u.pn - nsplit) * 256) + wc * 32 + 8 * fq;
#pragma unroll
    for (int ai = 0; ai < 2; ++ai)
#pragma unroll
      for (int m = 0; m < 4; ++m) {
        const int row = row0 + ai * 128 + m * 16;
        const float rs = ss ? rsqrtf(ss[row] * (1.f / 2048.f) + EPS) : 1.f;
#pragma unroll
        for (int bj = 0; bj < 2; ++bj) *(u32x4*)(ob + (size_t)row * ld + bj * 128) = pack8(acc[ai][bj][m][0] * rs, acc[ai][bj][m][1] * rs);
      }
  }
};

struct EpiQlat {
  unsigned char* Q0; float osc;
  __device__ __forceinline__ void operator()(const Acc& acc, const GUnit& u, int wr, int wc, int fr, int fq) const {
    const int row0 = u.pm * 256 + wr * 64 + fr;
    unsigned char* ob = Q0 + (size_t)u.pn * 256 + wc * 32 + 8 * fq;
#pragma unroll
    for (int ai = 0; ai < 2; ++ai)
#pragma unroll
      for (int m = 0; m < 4; ++m) {
        const int row = row0 + ai * 128 + m * 16;
#pragma unroll
        for (int bj = 0; bj < 2; ++bj) { const f32x4 a = acc[ai][bj][m][0] * osc, b = acc[ai][bj][m][1] * osc; u32x2 w;
          w[0] = __builtin_amdgcn_cvt_pk_fp8_f32(a[0], a[1], 0, false); w[0] = __builtin_amdgcn_cvt_pk_fp8_f32(a[2], a[3], w[0], true);
          w[1] = __builtin_amdgcn_cvt_pk_fp8_f32(b[0], b[1], 0, false); w[1] = __builtin_amdgcn_cvt_pk_fp8_f32(b[2], b[3], w[1], true);
          *(u32x2*)(ob + (size_t)row * 8192 + bj * 128) = w; }
      }
  }
};

struct EpiGate {
  unsigned char* Y; const unsigned char* Z; float osc;
  __device__ __forceinline__ void operator()(const Acc& acc, const GUnit& u, int wr, int wc, int fr, int fq) const {
    const int row0 = u.pm * 256 + wr * 64 + fr; const int col0 = u.pn * 256 + wc * 32 + 8 * fq;
#pragma unroll
    for (int ai = 0; ai < 2; ++ai)
#pragma unroll
      for (int m = 0; m < 4; ++m) {
        const size_t off = (size_t)(row0 + ai * 128 + m * 16) * 4096 + col0;
#pragma unroll
        for (int bj = 0; bj < 2; ++bj) {
          const u32x2 zw = *(const u32x2*)(Z + off + bj * 128);
          typedef float f32x2v __attribute__((ext_vector_type(2)));
          const f32x2v z0 = __builtin_amdgcn_cvt_pk_f32_fp8(zw[0], false), z1 = __builtin_amdgcn_cvt_pk_f32_fp8(zw[0], true), z2 = __builtin_amdgcn_cvt_pk_f32_fp8(zw[1], false), z3 = __builtin_amdgcn_cvt_pk_f32_fp8(zw[1], true);
          f32x4 a = acc[ai][bj][m][0] * osc, b = acc[ai][bj][m][1] * osc;
          a[0] *= silu_fast(z0[0]); a[1] *= silu_fast(z0[1]); a[2] *= silu_fast(z1[0]); a[3] *= silu_fast(z1[1]);
          b[0] *= silu_fast(z2[0]); b[1] *= silu_fast(z2[1]); b[2] *= silu_fast(z3[0]); b[3] *= silu_fast(z3[1]);
          u32x2 w; w[0] = __builtin_amdgcn_cvt_pk_fp8_f32(a[0], a[1], 0, false); w[0] = __builtin_amdgcn_cvt_pk_fp8_f32(a[2], a[3], w[0], true);
          w[1] = __builtin_amdgcn_cvt_pk_fp8_f32(b[0], b[1], 0, false); w[1] = __builtin_amdgcn_cvt_pk_fp8_f32(b[2], b[3], w[1], true);
          *(u32x2*)(Y + off + bj * 128) = w;
        }
      }
  }
};

struct EpiRes {
  const float* R; const bf16_t* RB; int ldrb; float* H; bf16_t* HB; int ldhb; float* ss; float osc;
  __device__ __forceinline__ void operator()(const Acc& acc, const GUnit& u, int wr, int wc, int fr, int fq) const {
    const int row0 = u.pm * 256 + wr * 64 + fr; const int col0 = u.pn * 256 + wc * 32 + 8 * fq;
#pragma unroll
    for (int ai = 0; ai < 2; ++ai)
#pragma unroll
      for (int m = 0; m < 4; ++m) {
        const int row = row0 + ai * 128 + m * 16; const size_t off = (size_t)row * 2048 + col0; float s = 0.f;
#pragma unroll
        for (int bj = 0; bj < 2; ++bj) {
          f32x4 r0, r1;
          if (R) { r0 = *(const f32x4*)(R + off + bj * 128); r1 = *(const f32x4*)(R + off + bj * 128 + 4); }
          else { const u32x4 rw = *(const u32x4*)(RB + (size_t)row * ldrb + col0 + bj * 128);
            r0 = (f32x4){bflo(rw[0]), bfhi(rw[0]), bflo(rw[1]), bfhi(rw[1])}; r1 = (f32x4){bflo(rw[2]), bfhi(rw[2]), bflo(rw[3]), bfhi(rw[3])}; }
          const f32x4 h0 = r0 + acc[ai][bj][m][0] * osc, h1 = r1 + acc[ai][bj][m][1] * osc;
          if (H) { *(f32x4*)(H + off + bj * 128) = h0; *(f32x4*)(H + off + bj * 128 + 4) = h1; }
          if (HB) *(u32x4*)(HB + (size_t)row * ldhb + col0 + bj * 128) = pack8(h0, h1);
          s += h0[0] * h0[0] + h0[1] * h0[1] + h0[2] * h0[2] + h0[3] * h0[3] + h1[0] * h1[0] + h1[1] * h1[1] + h1[2] * h1[2] + h1[3] * h1[3];
        }
        s = psum32(psum16(s));
        if (fq == 0) atomicAdd(ss + row, s);
      }
  }
};
}

struct CmA { __device__ __forceinline__ int operator()(int n) const {
  if (n < 4096) return n;
  if (n < 8192) return 5456 + (n - 4096);
  if (n < 8448) return 4096 + (n - 8192);
  if (n < 9472) return 4352 + (n - 8448);
  const int c = n - 9472;
  if (c < 32) return 5376 + c;
  if (c < 48) return 5440 + (c - 32);
  if (c >= 128 && c < 160) return 5376 + 32 + (c - 128);
  return -1; } };
struct CmAI { __device__ __forceinline__ int operator()(int n) const { return CmA{}(n + 8192); } };
struct CmOff { int off; __device__ __forceinline__ int operator()(int n) const { return n + off; } };

template <class CM, bool FP8 = false>
__device__ __forceinline__ void tconv_tile(bf16_t* dst, int ldD, const float* src, int ldS, int kt, int np, const float* gk, CM cm, float* tl, int tid, float wsc = 1.f) {
  {
    { const int c = tid & 63, r = tid >> 6; const int sc0 = cm(np * 128 + c), sc1 = cm(np * 128 + 64 + c);
      float v0[8], v1[8];
#pragma unroll
      for (int pass = 0; pass < 8; ++pass) { const int k = kt * 64 + pass * 8 + r; const float g = (gk ? gk[k] : 1.f) * wsc;
        v0[pass] = (sc0 >= 0) ? src[(size_t)k * ldS + sc0] * g : 0.f; v1[pass] = (sc1 >= 0) ? src[(size_t)k * ldS + sc1] * g : 0.f; }
#pragma unroll
      for (int pass = 0; pass < 8; ++pass) { tl[(pass * 8 + r) * 129 + c] = v0[pass]; tl[(pass * 8 + r) * 129 + 64 + c] = v1[pass]; } }
    __syncthreads();
#pragma unroll
    for (int hf = 0; hf < 2; ++hf) { const int nl = hf * 64 + (tid >> 3), kc = tid & 7; float v[8];
#pragma unroll
      for (int j = 0; j < 8; ++j) v[j] = tl[(kc * 8 + j) * 129 + nl];
      if constexpr (FP8) {
        u32x2 w; w[0] = __builtin_amdgcn_cvt_pk_fp8_f32(v[0], v[1], 0, false); w[0] = __builtin_amdgcn_cvt_pk_fp8_f32(v[2], v[3], w[0], true);
        w[1] = __builtin_amdgcn_cvt_pk_fp8_f32(v[4], v[5], 0, false); w[1] = __builtin_amdgcn_cvt_pk_fp8_f32(v[6], v[7], w[1], true);
        *(u32x2*)((unsigned char*)dst + (size_t)(np * 128 + nl) * ldD + kt * 64 + kc * 8) = w;
      } else {
      u32x4 w; w[0] = cvt_pk_bf16(v[0], v[1]); w[1] = cvt_pk_bf16(v[2], v[3]); w[2] = cvt_pk_bf16(v[4], v[5]); w[3] = cvt_pk_bf16(v[6], v[7]);
      *(u32x4*)(dst + (size_t)(np * 128 + nl) * ldD + kt * 64 + kc * 8) = w; } }
    __syncthreads();
  }
}
template <class CM, bool FP8 = false>
__device__ __forceinline__ void tconv(bf16_t* dst, int ldD, const float* src, int ldS, int Ktiles, int Ntiles, const float* gk, CM cm, float* tl, int bid, int nb, float wsc = 1.f) {
  int tid = threadIdx.x; asm volatile("" : "+v"(tid));
  const int Np = Ntiles >> 1;
  for (int tile = bid; tile < Ktiles * Np; tile += nb) tconv_tile<CM, FP8>(dst, ldD, src, ldS, tile / Np, tile % Np, gk, cm, tl, tid, wsc);
}

__device__ __forceinline__ void p0_prep(const Params& p, unsigned char* lds, int bid, int nb) {
  int tid = threadIdx.x; asm volatile("" : "+v"(tid));
  const int lane = tid & 63, wid = tid >> 6;
  float* tl = (float*)lds;
  unsigned char* ws = p.ws;
  { bf16_t* xb = (bf16_t*)(ws + OFF_QL0); unsigned char* xq = ws + OFF_XQ; float* ss0 = (float*)(ws + OFF_SS);
    for (int row = bid * 8 + wid; row < T; row += nb * 8) {
      const f32x4* src = (const f32x4*)(p.x + (size_t)row * D); float s = 0.f;
#pragma unroll
      for (int j = 0; j < 8; ++j) { const f32x4 v = src[lane + 64 * j]; s += v[0] * v[0] + v[1] * v[1] + v[2] * v[2] + v[3] * v[3];
        u32x2 o; o[0] = cvt_pk_bf16(v[0], v[1]); o[1] = cvt_pk_bf16(v[2], v[3]); *(u32x2*)(xb + (size_t)row * D + (lane + 64 * j) * 4) = o;
        unsigned q8 = __builtin_amdgcn_cvt_pk_fp8_f32(v[0], v[1], 0, false); q8 = __builtin_amdgcn_cvt_pk_fp8_f32(v[2], v[3], q8, true); *(unsigned*)(xq + (size_t)row * D + (lane + 64 * j) * 4) = q8; }
      s = wave_sum(s, lane); if (lane == 0) ss0[row] = s;
    }
    for (int i = bid * 512 + tid; i < 2 * T; i += nb * 512) ss0[T + i] = 0.f;
    { float* sm = (float*)(ws + OFF_SMALL);
      for (int i = bid * 512 + tid; i < SM_TOTAL; i += nb * 512) {
        float v;
        if (i < SM_KVN) v = p.kidx_norm[i]; else if (i < SM_RELB) v = p.kv_norm[i - SM_KVN]; else if (i < SM_BGRP) v = p.rel_bias[i - SM_RELB];
        else if (i < SM_SCALE) v = p.b_grp[i - SM_BGRP]; else if (i < SM_FINAL) v = p.scale_b[i - SM_SCALE]; else v = p.final_norm[i - SM_FINAL];
        sm[i] = v; } } }
  tconv<CmA, true>((bf16_t*)(ws + OFF_WA), 2048, p.w_in_a, 9552, 32, 128, p.norm_a, CmA{}, tl, bid, nb, 64.f);
  tconv((bf16_t*)(ws + OFF_WAI), 2048, p.w_in_a, 9552, 32, 24, p.norm_a, CmAI{}, tl, bid, nb);
  tconv<CmOff, true>((bf16_t*)(ws + OFF_WOUTA), 4096, p.w_out_a, 2048, 64, 32, nullptr, CmOff{0}, tl, bid, nb, 64.f);
  tconv((bf16_t*)(ws + OFF_WB) + (size_t)4096 * LDWB, LDWB, p.w_in_b, 8192, 32, 64, p.norm_b, CmOff{4096}, tl, bid, nb);
  for (int it = bid; it < 512; it += nb) { const int g = it >> 7, rem = it & 127;
    tconv_tile((bf16_t*)(ws + OFF_WG) + (size_t)g * 1048576, 1024, p.w_grp + (size_t)g * 1048576, 1024, rem >> 3, rem & 7, nullptr, CmOff{0}, tl, tid); }
  tconv((bf16_t*)(ws + OFF_WOUTB), 4096, p.w_out_b, 2048, 64, 32, nullptr, CmOff{0}, tl, bid, nb);
  for (int it = (bid + (nb >> 1)) % nb; it < 128; it += nb) {
    const int h = it >> 2, pair = h >> 1, hh = h & 1;
    tconv_tile<CmOff, true>((bf16_t*)(ws + OFF_WUV + (size_t)pair * 131072 + (size_t)hh * 128 * 512 + hh * 256), 512, p.w_uv + h * 128, 4096, it & 3, 0, nullptr, CmOff{0}, tl, tid, 16.f);
  }
  {
    unsigned char* wv = ws + OFF_WUV;
    for (int i = bid * 512 + tid; i < 32 * 128 * 16; i += nb * 512) {
      const int piece = i & 15, r = (i >> 4) & 127, ph = i >> 11; const int pair = ph >> 1, hh = ph & 1;
      *(u32x4*)(wv + (size_t)pair * 131072 + (size_t)(hh * 128 + r) * 512 + (1 - hh) * 256 + piece * 16) = (u32x4){0u, 0u, 0u, 0u};
    } }
  {
    bf16_t* wu = (bf16_t*)(ws + OFF_WU);
    for (int i = bid * 512 + tid; i < 4 * 2048 * 256; i += nb * 512) {
      const int p4 = i & 255, k = (i >> 8) & 2047, g = i >> 19;
      const f32x4 v = *(const f32x4*)(p.w_in_b + (size_t)k * 8192 + g * 1024 + p4 * 4) * p.norm_b[k];
      u32x2 o; o[0] = cvt_pk_bf16(v[0], v[1]); o[1] = cvt_pk_bf16(v[2], v[3]); *(u32x2*)(wu + (size_t)g * 2097152 + (size_t)k * 1024 + p4 * 4) = o;
    } }
  {
    unsigned char* wk = ws + OFF_WUK;
    for (int i = bid * 512 + tid; i < 16 * 512 * 64; i += nb * 512) {
      const int k4 = i & 63, n = (i >> 6) & 511, pr = i >> 15; const int hh = n >> 8, c = n & 255;
      unsigned w = 0u;
      if ((k4 >> 5) == hh) { const f32x4 v = *(const f32x4*)(p.w_uk + (size_t)c * 4096 + (2 * pr + hh) * 128 + (k4 & 31) * 4) * 16.f;
        w = __builtin_amdgcn_cvt_pk_fp8_f32(v[0], v[1], 0, false); w = __builtin_amdgcn_cvt_pk_fp8_f32(v[2], v[3], w, true); }
      *(unsigned*)(wk + (size_t)pr * 131072 + (size_t)n * 256 + k4 * 4) = w;
    } }
}

__device__ __forceinline__ void p3_ckvnorm(const Params& p, int bid, int nb) {
  int tid = threadIdx.x; asm volatile("" : "+v"(tid));
  const int lane = tid & 63, wid = tid >> 6;
  const float* cr = (const float*)(p.ws + OFF_CKVR); bf16_t* cn = (bf16_t*)(p.ws + OFF_CKVN);
  const f32x4 g = *(const f32x4*)((const float*)(p.ws + OFF_SMALL) + SM_KVN + lane * 4);
  for (int row = bid * 8 + wid; row < T; row += nb * 8) {
    const f32x4 v = *(const f32x4*)(cr + (size_t)row * 256 + lane * 4);
    float s = v[0] * v[0] + v[1] * v[1] + v[2] * v[2] + v[3] * v[3]; s = wave_sum(s, lane);
    const float r = rsqrtf(s * (1.f / 256.f) + EPS);
    u32x2 o; o[0] = cvt_pk_bf16(v[0] * r * g[0], v[1] * r * g[1]); o[1] = cvt_pk_bf16(v[2] * r * g[2], v[3] * r * g[3]);
    *(u32x2*)(cn + (size_t)row * 256 + lane * 4) = o;
  }
}

__device__ __forceinline__ void p3_indexer(const Params& p, unsigned char* lds, int bid, int nb, int rep_sc, int rep_sel) {
  float* sc = (float*)lds;
  const bf16_t* qidx = (const bf16_t*)(p.ws + OFF_QIDX); const bf16_t* kidx = (const bf16_t*)(p.ws + OFF_KIDX); const float* widx = (const float*)(p.ws + OFF_WIDX);
  unsigned short* idxo = (unsigned short*)(p.ws + OFF_IDX);
  int tid = threadIdx.x; asm volatile("" : "+v"(tid));
  const int lane = tid & 63, wid = tid >> 6, h = lane >> 5, l31 = lane & 31;
  for (int round = 0; round * nb + bid < T / 16; ++round) {
    const int item = round * nb + bid;
    const int b = item & 15; int tile = item >> 4; { const int r16 = tile >> 4, j = tile & 15; tile = r16 * 16 + ((r16 & 1) ? 15 - j : j); }
    const int t0 = tile * 16;
    if (t0 < 256) {
      const int tok = tid >> 5, j0 = (tid & 31) * 8, t = t0 + tok;
      unsigned short v[8];
#pragma unroll
      for (int j = 0; j < 8; ++j) v[j] = (unsigned short)((j0 + j <= t) ? (j0 + j) : 0);
      u32x4 w; w[0] = v[0] | ((unsigned)v[1] << 16); w[1] = v[2] | ((unsigned)v[3] << 16); w[2] = v[4] | ((unsigned)v[5] << 16); w[3] = v[6] | ((unsigned)v[7] << 16);
      *(u32x4*)(idxo + (size_t)(b * L + t) * 256 + j0) = w;
      continue;
    }
    for (int rsc = 0; rsc < rep_sc; ++rsc) {
      const int tok = l31 >> 4, head = l31 & 15;
      const bf16_t* arow = qidx + (size_t)(b * L + t0 + 2 * wid + tok) * 1024 + head * 64 + 8 * h;
      bf16x8 aq[4];
#pragma unroll
      for (int ks = 0; ks < 4; ++ks) aq[ks] = *(const bf16x8*)(arow + 16 * ks);
      float wv[16];
#pragma unroll
      for (int tk = 0; tk < 2; ++tk) {
        const float* wp = widx + (size_t)(b * L + t0 + 2 * wid + tk) * 16 + 4 * h;
        const f32x4 w0 = *(const f32x4*)(wp), w1 = *(const f32x4*)(wp + 8);
#pragma unroll
        for (int i = 0; i < 4; ++i) { wv[tk * 8 + i] = w0[i] * 0.125f; wv[tk * 8 + 4 + i] = w1[i] * 0.125f; }
      }
      const unsigned char* kb = (const unsigned char*)(kidx + (size_t)b * 64 * 2048) + tid * 16;
      LAS unsigned char* stgb = (LAS unsigned char*)lds + 131072;
      const int nkt = ((t0 + 15) >> 5) + 1, ngr = (nkt + 1) >> 1;
      u32x4 sv = *(const u32x4*)(kb);
      *(LAS u32x4*)(stgb + tid * 16) = sv;
      if (ngr > 1) sv = *(const u32x4*)(kb + 8192);
      __syncthreads();
      for (int gr = 0; gr < ngr; ++gr) {
        if (gr + 1 < ngr) *(LAS u32x4*)(stgb + ((gr + 1) & 1) * 8192 + tid * 16) = sv;
        if (gr + 2 < ngr) sv = *(const u32x4*)(kb + (size_t)(gr + 2) * 8192);
        const LAS unsigned char* bb = stgb + (gr & 1) * 8192 + lane * 16;
#pragma unroll
        for (int q = 0; q < 2; ++q) {
          f32x16 acc;
#pragma unroll
          for (int i = 0; i < 16; ++i) acc[i] = 0.f;
#pragma unroll
          for (int ks = 0; ks < 4; ++ks) { const bf16x8 bfr = *(const LAS bf16x8*)(bb + q * 4096 + ks * 1024); acc = __builtin_amdgcn_mfma_f32_32x32x16_bf16(aq[ks], bfr, acc, 0, 0, 0); }
          float s0 = 0.f, s1 = 0.f;
#pragma unroll
          for (int i = 0; i < 8; ++i) { s0 += wv[i] * relu_i(acc[i]); s1 += wv[8 + i] * relu_i(acc[8 + i]); }
          s0 = psum32(s0); s1 = psum32(s1);
          sc[(2 * wid + h) * 2048 + 32 * (2 * gr + q) + l31] = h ? s1 : s0;
        }
        __syncthreads();
      }
    }
    __syncthreads();
    LAS unsigned* hist = (LAS unsigned*)((LAS unsigned char*)lds + 131072) + wid * 256;
    LAS unsigned* cand = (LAS unsigned*)((LAS unsigned char*)lds + 131072 + 8192) + wid * 128;
    for (int rsel = 0; rsel < rep_sel; ++rsel)
    for (int qq = 0; qq < 2; ++qq) {
      const int qi = 2 * wid + qq, t = t0 + qi;
      float v[32];
#pragma unroll
      for (int j = 0; j < 32; ++j) v[j] = sc[qi * 2048 + lane + 64 * j];
      float mn = 3.0e38f, mx = -3.0e38f;
#pragma unroll
      for (int j = 0; j < 32; ++j) { const bool valid = (lane + 64 * j) <= t; mn = valid ? fminf(mn, v[j]) : mn; mx = valid ? fmaxf(mx, v[j]) : mx; }
      mn = wave_min(mn); mx = wave_max(mx);
      const float scale = (mx > mn) ? 255.f / (mx - mn) : 0.f;
      *(LAS u32x4*)(hist + lane * 4) = (u32x4){0u, 0u, 0u, 0u};
      asm volatile("" ::: "memory");
#pragma unroll
      for (int j = 0; j < 32; ++j) { const bool valid = (lane + 64 * j) <= t; const int bin = min((int)((v[j] - mn) * scale), 255);
        if (valid) __hip_atomic_fetch_add(hist + bin, 1u, __ATOMIC_RELAXED, __HIP_MEMORY_SCOPE_WORKGROUP); }
      asm volatile("s_waitcnt lgkmcnt(0)" ::: "memory");
      const u32x4 h4 = *(const LAS u32x4*)(hist + lane * 4);
      const int tot = (int)(h4[0] + h4[1] + h4[2] + h4[3]);
      int px = tot;
      px += __builtin_amdgcn_update_dpp(0, px, 0x111, 0xf, 0xf, true); px += __builtin_amdgcn_update_dpp(0, px, 0x112, 0xf, 0xf, true);
      px += __builtin_amdgcn_update_dpp(0, px, 0x114, 0xf, 0xf, true); px += __builtin_amdgcn_update_dpp(0, px, 0x118, 0xf, 0xf, true);
      const int rt0 = __builtin_amdgcn_readlane(px, 15), rt1 = __builtin_amdgcn_readlane(px, 31), rt2 = __builtin_amdgcn_readlane(px, 47), rt3 = __builtin_amdgcn_readlane(px, 63);
      const int pre = px + (lane >= 16 ? rt0 : 0) + (lane >= 32 ? rt1 : 0) + (lane >= 48 ? rt2 : 0);
      const int suf = (rt0 + rt1 + rt2 + rt3) - pre + tot;
      const int S3 = suf - tot + (int)h4[3], S2 = S3 + (int)h4[2], S1 = S2 + (int)h4[1], S0 = S1 + (int)h4[0];
      const unsigned long long bm = __ballot(S0 >= 256);
      const int lstar = 63 - __clzll(bm);
      const int myB = S3 >= 256 ? 3 : (S2 >= 256 ? 2 : (S1 >= 256 ? 1 : 0));
      const int mySB = S3 >= 256 ? S3 : (S2 >= 256 ? S2 : (S1 >= 256 ? S1 : S0));
      const int myh = (int)(S3 >= 256 ? h4[3] : (S2 >= 256 ? h4[2] : (S1 >= 256 ? h4[1] : h4[0])));
      const int B = lstar * 4 + __builtin_amdgcn_readlane(myB, lstar);
      const int m = __builtin_amdgcn_readlane(myh, lstar);
      const int c_hi = __builtin_amdgcn_readlane(mySB, lstar) - m, need = 256 - c_hi;
      unsigned short* op = idxo + (size_t)(b * L + t) * 256;
      int base = 0, cbn = 0;
#pragma unroll
      for (int j = 0; j < 32; ++j) {
        const int e = lane + 64 * j; const bool valid = e <= t; const int bin = min((int)((v[j] - mn) * scale), 255);
        const bool hi = valid && bin > B, eq = valid && bin == B;
        const unsigned long long hm = __ballot(hi), em = __ballot(eq);
        const int pos = base + (int)__builtin_amdgcn_mbcnt_hi((unsigned)(hm >> 32), __builtin_amdgcn_mbcnt_lo((unsigned)hm, 0u));
        const int cpos = cbn + (int)__builtin_amdgcn_mbcnt_hi((unsigned)(em >> 32), __builtin_amdgcn_mbcnt_lo((unsigned)em, 0u));
        if (hi && pos < 256) op[pos] = (unsigned short)e;
        if (eq && cpos < 64) { const unsigned bits = __float_as_uint(v[j]); cand[2 * cpos] = bits ^ ((bits >> 31) ? 0xFFFFFFFFu : 0x80000000u); cand[2 * cpos + 1] = (unsigned)e; }
        base += __popcll(hm); cbn += __popcll(em);
      }
      if (m <= 64) {
        asm volatile("s_waitcnt lgkmcnt(0)" ::: "memory");
        const unsigned ck = (lane < m) ? cand[2 * lane] : 0u, ce = (lane < m) ? cand[2 * lane + 1] : 0xffffu;
        int rank = 0;
        for (int jj = 0; jj < m; ++jj) { const unsigned kj = __builtin_amdgcn_readlane(ck, jj), ej = __builtin_amdgcn_readlane(ce, jj); rank += (kj > ck || (kj == ck && ej < ce)) ? 1 : 0; }
        const bool selc = (lane < m) && (rank < need);
        const unsigned long long sm = __ballot(selc);
        const int pos = c_hi + (int)__builtin_amdgcn_mbcnt_hi((unsigned)(sm >> 32), __builtin_amdgcn_mbcnt_lo((unsigned)sm, 0u));
        if (selc && pos < 256) op[pos] = (unsigned short)ce;
      } else {
#define KEYOF(j) (((lane + 64 * (j)) <= t) ? (__float_as_uint(v[j]) ^ ((__float_as_uint(v[j]) >> 31) ? 0xFFFFFFFFu : 0x80000000u)) : 0u)
        unsigned prefix = 0u;
        for (int bit = 31; bit >= 0; --bit) {
          const unsigned cnd = prefix | (1u << bit); int cnt = 0;
#pragma unroll
          for (int j = 0; j < 32; ++j) cnt += __popcll(__ballot(KEYOF(j) >= cnd));
          if (cnt >= 256) prefix = cnd;
        }
        int cgt = 0;
#pragma unroll
        for (int j = 0; j < 32; ++j) cgt += __popcll(__ballot(KEYOF(j) > prefix));
        const int need2 = 256 - cgt; int base2 = 0, tb = 0;
#pragma unroll
        for (int j = 0; j < 32; ++j) {
          const unsigned uj = KEYOF(j); const bool gt = uj > prefix, eq = (uj == prefix);
          const unsigned long long eqm = __ballot(eq);
          const int trank = tb + (int)__builtin_amdgcn_mbcnt_hi((unsigned)(eqm >> 32), __builtin_amdgcn_mbcnt_lo((unsigned)eqm, 0u));
          const bool sel = gt || (eq && trank < need2);
          const unsigned long long sm = __ballot(sel);
          const int pos = base2 + (int)__builtin_amdgcn_mbcnt_hi((unsigned)(sm >> 32), __builtin_amdgcn_mbcnt_lo((unsigned)sm, 0u));
          if (sel && pos < 256) op[pos] = (unsigned short)(lane + 64 * j);
          base2 += __popcll(sm); tb += __popcll(eqm);
        }
#undef KEYOF
      }
    }
    __syncthreads();
  }
}

__device__ __forceinline__ void pair_sync(LAS unsigned* cnt, unsigned target, int lane) {
  asm volatile("" ::: "memory");
  if (lane == 0) __hip_atomic_fetch_add(cnt, 1u, __ATOMIC_RELAXED, __HIP_MEMORY_SCOPE_WORKGROUP);
  while (__hip_atomic_load(cnt, __ATOMIC_RELAXED, __HIP_MEMORY_SCOPE_WORKGROUP) < target) __builtin_amdgcn_s_sleep(1);
  asm volatile("" ::: "memory");
}
constexpr int CROW = 544;
constexpr int CTOK = 32 * CROW;
constexpr int CBUF = 4 * CTOK;
__device__ __forceinline__ void p4_attn(const Params& p, unsigned char* lds, int bid, int nb, bool dry) {
  LAS unsigned char* cbuf = (LAS unsigned char*)lds;
  LAS float* biasd = (LAS float*)((LAS unsigned char*)lds + 2 * CBUF);
  LAS unsigned short* idxs = (LAS unsigned short*)((LAS unsigned char*)lds + 2 * CBUF + 129 * 32 * 4);
  const bf16_t* ckvn = (const bf16_t*)(p.ws + OFF_CKVN); const unsigned short* idxg = (const unsigned short*)(p.ws + OFF_IDX);
  unsigned char* QL = p.ws + OFF_QL0;
  int tid = threadIdx.x; asm volatile("" : "+v"(tid));
  const int lane = tid & 63, wid = __builtin_amdgcn_readfirstlane(tid >> 6), g = lane >> 4, r16 = lane & 15;
  for (int i = tid; i < 129 * 32; i += 512) {
    const int d = i >> 5, hd = i & 31; int bucket = d;
    if (d >= 16) { bucket = 16 + (d >= 19) + (d >= 21) + (d >= 24) + (d >= 27) + (d >= 31) + (d >= 35) + (d >= 40) + (d >= 46) + (d >= 52) + (d >= 59) + (d >= 67) + (d >= 77) + (d >= 87) + (d >= 99) + (d >= 113); }
    biasd[i] = ((const float*)(p.ws + OFF_SMALL))[SM_RELB + bucket * 32 + hd] * LOG2E;
  }
  LAS unsigned* pcnt = (LAS unsigned*)((LAS unsigned char*)lds + 2 * CBUF + 129 * 32 * 4 + 2048) + (wid >> 1);
  if (tid < 4) ((LAS unsigned*)((LAS unsigned char*)lds + 2 * CBUF + 129 * 32 * 4 + 2048))[tid] = 0u;
  __syncthreads();
  unsigned epoch = 0u;
  const int tok = wid >> 1, hw = wid & 1, head = hw * 16 + r16;
  const float SC = 0.08838834764831845f * LOG2E;
  const int qoff = 16 * (g ^ (r16 >> 3));
  const int q4 = r16 >> 2, pp = r16 & 3;
  const int troff = (4 * g + q4) * CROW + 16 * ((pp >> 1) ^ (g >> 1)) + 8 * (pp & 1);
  const int wrow = 16 * hw + 8 * (lane >> 5), wch = lane & 31;
  for (int round = 0; round * nb < T / 4; ++round) {
    const int item = round * nb + (bid + round * 37) % nb;
    const int tg0 = item * 4, b = tg0 >> 11, t0 = tg0 & 2047, t = t0 + tok, tg = tg0 + tok;
    const int nk = min(t + 1, 256), nkmax = min(t0 + 4, 256), nch = (nkmax + 31) >> 5;
    ((LAS unsigned*)idxs)[tid] = ((const unsigned*)(idxg + (size_t)tg0 * 256))[tid];
    unsigned char* qrow = QL + (size_t)tg * 8192 + head * 256;
    bf16x8 qB[8];
#pragma unroll
    for (int s = 0; s < 8; ++s) { const u32x2 qw = *(const u32x2*)(qrow + 32 * s + 8 * g);
      typedef float f32x2v __attribute__((ext_vector_type(2)));
      const f32x2v a0 = __builtin_amdgcn_cvt_pk_f32_fp8(qw[0], false), a1 = __builtin_amdgcn_cvt_pk_f32_fp8(qw[0], true), a2 = __builtin_amdgcn_cvt_pk_f32_fp8(qw[1], false), a3 = __builtin_amdgcn_cvt_pk_f32_fp8(qw[1], true);
      u32x4 pw; pw[0] = cvt_pk_bf16(a0[0], a0[1]); pw[1] = cvt_pk_bf16(a1[0], a1[1]); pw[2] = cvt_pk_bf16(a2[0], a2[1]); pw[3] = cvt_pk_bf16(a3[0], a3[1]);
      union { u32x4 u; bf16x8 v; } cv; cv.u = pw; qB[s] = cv.v; }
    epoch += 2u; pair_sync(pcnt, epoch, lane);
    u32x4 stg[8];
    const bf16_t* cbase = ckvn + (size_t)b * L * 256 + wch * 8;
#define P4_LOAD(ch) do { const u32x4 kk_ = *(const LAS u32x4*)(idxs + tok * 256 + (ch) * 32 + wrow); \
      _Pragma("unroll") for (int i = 0; i < 8; ++i) { \
      const int key = (int)((kk_[i >> 1] >> (16 * (i & 1))) & 0xffffu); stg[i] = *(const u32x4*)(cbase + (size_t)key * 256); } } while (0)
#define P4_WRITE(bufp) do { _Pragma("unroll") for (int i = 0; i < 8; ++i) \
      *(LAS u32x4*)((bufp) + (wrow + i) * CROW + 16 * (wch ^ (lane >> 5))) = stg[i]; } while (0)
    P4_LOAD(0);
    P4_WRITE(cbuf + tok * CTOK);
    if (nch > 1) P4_LOAD(1);
    float m_run = -1e30f, l_run = 0.f;
    f32x4 o[16];
#pragma unroll
    for (int ct = 0; ct < 16; ++ct) o[ct] = (f32x4){0.f, 0.f, 0.f, 0.f};
    epoch += 2u; pair_sync(pcnt, epoch, lane);
    for (int ch = 0; ch < nch; ++ch) {
      LAS unsigned char* cb = cbuf + (ch & 1) * CBUF + tok * CTOK;
      if (ch + 1 < nch) { P4_WRITE(cbuf + ((ch + 1) & 1) * CBUF + tok * CTOK); if (ch + 2 < nch) P4_LOAD(ch + 2); }
      f32x4 s0 = (f32x4){0.f, 0.f, 0.f, 0.f}, s1 = (f32x4){0.f, 0.f, 0.f, 0.f};
#pragma unroll
      for (int s = 0; s < 8; ++s) {
        const bf16x8 a0 = *(const LAS bf16x8*)(cb + r16 * CROW + s * 64 + qoff);
        const bf16x8 a1 = *(const LAS bf16x8*)(cb + (16 + r16) * CROW + s * 64 + qoff);
        s0 = __builtin_amdgcn_mfma_f32_16x16x32_bf16(a0, qB[s], s0, 0, 0, 0);
        s1 = __builtin_amdgcn_mfma_f32_16x16x32_bf16(a1, qB[s], s1, 0, 0, 0);
      }
      const int slotb = ch * 32 + 4 * g;
      const u32x2 k0 = *(const LAS u32x2*)(idxs + tok * 256 + slotb), k1 = *(const LAS u32x2*)(idxs + tok * 256 + slotb + 16);
      float lg0[4], lg1[4]; float mx = -1e30f;
      const bool full = (ch * 32 + 32 <= nk);
      int dd0[4], dd1[4]; int dmin = 1 << 20;
#pragma unroll
      for (int i = 0; i < 4; ++i) {
        const int key0 = (int)((k0[i >> 1] >> (16 * (i & 1))) & 0xffffu), key1 = (int)((k1[i >> 1] >> (16 * (i & 1))) & 0xffffu);
        dd0[i] = t - key0; dd1[i] = t - key1; dmin = min(dmin, min(dd0[i], dd1[i]));
      }
      if (__ballot(dmin < 128) == 0ull) {
        const float bfar = biasd[128 * 32 + head];
#pragma unroll
        for (int i = 0; i < 4; ++i) { lg0[i] = s0[i] * SC + bfar; lg1[i] = s1[i] * SC + bfar; }
      } else {
#pragma unroll
        for (int i = 0; i < 4; ++i) {
          const int d0 = min(max(dd0[i], 0), 128), d1 = min(max(dd1[i], 0), 128);
          lg0[i] = s0[i] * SC + biasd[d0 * 32 + head];
          lg1[i] = s1[i] * SC + biasd[d1 * 32 + head];
        }
      }
#pragma unroll
      for (int i = 0; i < 4; ++i) {
        if (!full) {
          lg0[i] = (slotb + i < nk) ? lg0[i] : -1e30f;
          lg1[i] = (slotb + 16 + i < nk) ? lg1[i] : -1e30f;
        }
        mx = __builtin_fmaxf(__builtin_fmaxf(mx, lg0[i]), lg1[i]);
      }
      mx = pmax32(pmax16(mx));
      float alpha = 1.f;
      if (__ballot(mx > m_run + 8.f) != 0ull) {
        const float m_new = vmax(m_run, mx); alpha = __builtin_amdgcn_exp2f(m_run - m_new); m_run = m_new;
#pragma unroll
        for (int ct = 0; ct < 16; ++ct) o[ct] *= alpha;
      }
      float ps = 0.f; f32x4 p0, p1;
#pragma unroll
      for (int i = 0; i < 4; ++i) { p0[i] = __builtin_amdgcn_exp2f(lg0[i] - m_run); p1[i] = __builtin_amdgcn_exp2f(lg1[i] - m_run); ps += p0[i] + p1[i]; }
      l_run = l_run * alpha + ps;
      const u32x4 pw = pack8(p0, p1);
      bf16x8 pb; { union { u32x4 u; bf16x8 v; } cv; cv.u = pw; pb = cv.v; }
      LAS unsigned char* trb = cb + troff;
#pragma unroll
      for (int ct = 0; ct < 16; ++ct) {
        const s16x4 ta = __builtin_amdgcn_ds_read_tr16_b64_v4i16((LAS s16x4*)(trb + 32 * ct));
        const s16x4 tb = __builtin_amdgcn_ds_read_tr16_b64_v4i16((LAS s16x4*)(trb + 16 * CROW + 32 * ct));
        const bf16x8 a = {ta[0], ta[1], ta[2], ta[3], tb[0], tb[1], tb[2], tb[3]};
        o[ct] = __builtin_amdgcn_mfma_f32_16x16x32_bf16(a, pb, o[ct], 0, 0, 0);
      }
      epoch += 2u; pair_sync(pcnt, epoch, lane);
    }
    const float l = psum32(psum16(l_run));
    const float inv = 16.f / l;
    unsigned char* orow = qrow + 4 * g;
#pragma unroll
    for (int ct = 0; ct < 16; ++ct) {
      unsigned w = __builtin_amdgcn_cvt_pk_fp8_f32(o[ct][0] * inv, o[ct][1] * inv, 0, false); w = __builtin_amdgcn_cvt_pk_fp8_f32(o[ct][2] * inv, o[ct][3] * inv, w, true);
      if (!dry) *(unsigned*)(orow + 16 * ct) = w;
    }
#undef P4_LOAD
#undef P4_WRITE
  }
}

__device__ __forceinline__ void p8_pool(const Params& p, int bid, int nb) {
  const bf16_t* U = (const bf16_t*)(p.ws + OFF_RQ); const bf16_t* Z = (const bf16_t*)(p.ws + OFF_RZ); bf16_t* Y = (bf16_t*)p.out;
  int tid = threadIdx.x; asm volatile("" : "+v"(tid));
  const int n0 = tid * 8, w = 2 << (tid >> 7);
  float bg[8], scl[8];
#pragma unroll
  for (int j = 0; j < 8; ++j) { bg[j] = ((const float*)(p.ws + OFF_SMALL))[SM_BGRP + n0 + j]; scl[j] = ((const float*)(p.ws + OFF_SMALL))[SM_SCALE + n0 + j]; }
  for (int item = bid; item < T / 32; item += nb) {
    const int tg0 = item * 32, t0 = tg0 & 2047;
    const bf16_t* ub = U + (size_t)(tg0 - t0) * 4096 + n0;
    float sum[8];
#pragma unroll
    for (int j = 0; j < 8; ++j) sum[j] = 0.f;
    { u32x4 pv[15];
#pragma unroll
      for (int k = 1; k < 16; ++k) { const int s = t0 - k; pv[k - 1] = (k < w && s >= 0) ? *(const u32x4*)(ub + (size_t)s * 4096) : (u32x4){0u, 0u, 0u, 0u}; }
#pragma unroll
      for (int k = 0; k < 15; ++k)
#pragma unroll
        for (int j = 0; j < 4; ++j) { sum[2 * j] += bflo(pv[k][j]); sum[2 * j + 1] += bfhi(pv[k][j]); } }
    for (int tb = 0; tb < 32; tb += 4) {
      u32x4 cv[4], zv[4], ov[4];
#pragma unroll
      for (int k = 0; k < 4; ++k) {
        const int t = t0 + tb + k;
        cv[k] = *(const u32x4*)(ub + (size_t)t * 4096);
        zv[k] = *(const u32x4*)(Z + (size_t)(tg0 + tb + k) * 4096 + n0);
        ov[k] = (t - w + 1 >= 0) ? *(const u32x4*)(ub + (size_t)(t - w + 1) * 4096) : (u32x4){0u, 0u, 0u, 0u};
      }
#pragma unroll
      for (int k = 0; k < 4; ++k) {
        const int t = t0 + tb + k;
        float cur[8], zf[8], y[8];
#pragma unroll
        for (int j = 0; j < 4; ++j) { cur[2 * j] = bflo(cv[k][j]); cur[2 * j + 1] = bfhi(cv[k][j]); zf[2 * j] = bflo(zv[k][j]); zf[2 * j + 1] = bfhi(zv[k][j]); }
        const float icnt = __builtin_amdgcn_rcpf((float)min(w, t + 1));
#pragma unroll
        for (int j = 0; j < 8; ++j) { sum[j] += cur[j]; y[j] = ((sum[j] * icnt - cur[j]) + bg[j]) * scl[j] * silu_fast(zf[j]); }
        u32x4 o; o[0] = cvt_pk_bf16(y[0], y[1]); o[1] = cvt_pk_bf16(y[2], y[3]); o[2] = cvt_pk_bf16(y[4], y[5]); o[3] = cvt_pk_bf16(y[6], y[7]);
        *(u32x4*)(Y + (size_t)(tg0 + tb + k) * 4096 + n0) = o;
#pragma unroll
        for (int j = 0; j < 4; ++j) { sum[2 * j] -= bflo(ov[k][j]); sum[2 * j + 1] -= bfhi(ov[k][j]); }
        asm volatile("" ::: "memory");
      }
    }
  }
}

__device__ __forceinline__ void p10_final(const Params& p, int bid, int nb) {
  int tid = threadIdx.x; asm volatile("" : "+v"(tid));
  const int lane = tid & 63, wid = tid >> 6;
  const float* ss2 = (const float*)(p.ws + OFF_SS) + 2 * T;
  const bf16_t* h2 = (const bf16_t*)(p.ws + OFF_RQ);
  f32x4 g[8];
#pragma unroll
  for (int j = 0; j < 8; ++j) g[j] = *(const f32x4*)((const float*)(p.ws + OFF_SMALL) + SM_FINAL + (lane + 64 * j) * 4);
  for (int row = bid * 8 + wid; row < T; row += nb * 8) {
    const float r = rsqrtf(ss2[row] * (1.f / 2048.f) + EPS);
    f32x4* ptr = (f32x4*)(p.out + (size_t)row * D);
    u32x2 hv[8];
#pragma unroll
    for (int j = 0; j < 8; ++j) hv[j] = *(const u32x2*)(h2 + (size_t)row * D + (lane + 64 * j) * 4);
#pragma unroll
    for (int j = 0; j < 8; ++j) { const f32x4 v = {bflo(hv[j][0]), bfhi(hv[j][0]), bflo(hv[j][1]), bfhi(hv[j][1])}; ptr[lane + 64 * j] = v * r * g[j]; }
  }
}

__device__ __forceinline__ void grid_bar(unsigned* ctr, unsigned target) {
  __syncthreads();
  if (threadIdx.x == 0) {
    __builtin_amdgcn_fence(__ATOMIC_RELEASE, "agent");
    asm volatile("s_waitcnt vmcnt(0)" ::: "memory");
    __hip_atomic_fetch_add(ctr, 1u, __ATOMIC_RELAXED, __HIP_MEMORY_SCOPE_AGENT);
    while (__hip_atomic_load(ctr, __ATOMIC_RELAXED, __HIP_MEMORY_SCOPE_AGENT) < target) __builtin_amdgcn_s_sleep(2);
    __builtin_amdgcn_fence(__ATOMIC_ACQUIRE, "agent");
    asm volatile("s_waitcnt vmcnt(0)" ::: "memory");
  }
  __syncthreads();
}

__global__ void __launch_bounds__(512, 2) fwd_mega(Params p) {
  extern __shared__ __attribute__((aligned(16))) unsigned char lds[];
  cg::grid_group grid = cg::this_grid();
  const int bid = blockIdx.x, nb = gridDim.x;
  unsigned char* ws = p.ws;
  LAS unsigned char* gl = (LAS unsigned char*)lds;
  float* ss = (float*)(ws + OFF_SS);
  unsigned* bar = (unsigned*)(ws + OFF_BAR);

#define REPS(k)
#define DRY false
  if (bid == 0 && threadIdx.x == 0) __hip_atomic_store(bar, 0u, __ATOMIC_RELAXED, __HIP_MEMORY_SCOPE_AGENT);
  REPS(0) { p0_prep(p, lds, bid, nb); __syncthreads(); }
  grid.sync();

  REPS(1) {
    g8::Sched S; S.init(16, 8, nb, (bid + (nb >> 1)) % nb); S.A0 = (const char*)(ws + OFF_WG); S.sAm = (size_t)256 * 1024 * 2; S.B0 = (const char*)(ws + OFF_WU); S.sBn = (size_t)256 * 1024 * 2; S.sBg = (size_t)2048 * 1024 * 2; S.gshift = 2;
    g8::EpiBf16 E{(bf16_t*)(ws + OFF_WB), nullptr, 1 << 30, LDWB, nullptr};
    g8::gemm_phase(gl, 1024, 1024, 1024, S, E);
  }
  REPS(2) {
    { g8::Sched S; S.init(128, 32, nb, bid); S.A0 = (const char*)(ws + OFF_XQ); S.sAm = (size_t)256 * 2048; S.B0 = (const char*)(ws + OFF_WA); S.sBn = (size_t)256 * 2048;
      g8::EpiProjA E{ss, (bf16_t*)(ws + OFF_RQ), (bf16_t*)(ws + OFF_RZ), (float*)(ws + OFF_CKVR), (bf16_t*)(ws + OFF_QIDX), (bf16_t*)(ws + OFF_KIDX), (float*)(ws + OFF_WIDX), (const float*)(ws + OFF_SMALL) + SM_KIDXN, 0, 1.f / 64.f};
      g8::gemm_phase<g8::EpiProjA, true>(gl, 1024, 1024, 1024, S, E); }
    { g8::Sched S; S.init(128, 6, nb, bid); S.A0 = (const char*)(ws + OFF_QL0); S.sAm = (size_t)256 * 2048 * 2; S.B0 = (const char*)(ws + OFF_WAI); S.sBn = (size_t)256 * 2048 * 2;
      g8::EpiProjA E{ss, (bf16_t*)(ws + OFF_RQ), (bf16_t*)(ws + OFF_RZ), (float*)(ws + OFF_CKVR), (bf16_t*)(ws + OFF_QIDX), (bf16_t*)(ws + OFF_KIDX), (float*)(ws + OFF_WIDX), (const float*)(ws + OFF_SMALL) + SM_KIDXN, 32, 1.f};
      g8::gemm_phase(gl, 2048, 2048, 2048, S, E); }
  }
  grid_bar(bar, (unsigned)(1 * nb));

  REPS(3) { p3_indexer(p, lds, bid, nb, 1, 1); __syncthreads(); }
  REPS(11) { p3_ckvnorm(p, bid, nb); }
  __syncthreads();
  REPS(12) {
    g8::Sched S; S.init(128, 32, nb, bid); S.A0 = (const char*)(ws + OFF_RQ); S.sAm = (size_t)256 * 4096; S.sAn = 256; S.anshift = 1; S.B0 = (const char*)(ws + OFF_WUK); S.sBn = (size_t)256 * 256;
    g8::EpiQlat E{ws + OFF_QL0, 1.f / 16.f};
    g8::gemm_phase<g8::EpiQlat, true, 2>(gl, 128, 2048, 128, S, E);
  }
  grid_bar(bar, (unsigned)(2 * nb));

  REPS(4) { p4_attn(p, lds, bid, nb, DRY); __syncthreads(); }
  grid_bar(bar, (unsigned)(3 * nb));

  REPS(5) {
    g8::Sched S; S.init(128, 16, nb, bid); S.A0 = (const char*)(ws + OFF_QL0); S.sAm = (size_t)256 * 8192; S.sAn = 512; S.B0 = (const char*)(ws + OFF_WUV); S.sBn = (size_t)256 * 512;
    g8::EpiGate E{ws + OFF_RQ, ws + OFF_RZ, 16.f / 256.f};
    g8::gemm_phase<g8::EpiGate, true, 1>(gl, 256, 4096, 256, S, E);
  }
  grid_bar(bar, (unsigned)(4 * nb));

  REPS(6) {
    g8::Sched S; S.init(128, 8, nb, bid); S.A0 = (const char*)(ws + OFF_RQ); S.sAm = (size_t)256 * 4096; S.B0 = (const char*)(ws + OFF_WOUTA); S.sBn = (size_t)256 * 4096;
    g8::EpiRes E{p.x, nullptr, 0, nullptr, (bf16_t*)(ws + OFF_QL0), LDH, ss + T, 1.f / 1024.f};
    g8::gemm_phase<g8::EpiRes, true>(gl, 2048, 2048, 2048, S, E);
  }
  grid_bar(bar, (unsigned)(5 * nb));

  REPS(7) {
    g8::Sched S; S.init(128, 32, nb, bid); S.A0 = (const char*)(ws + OFF_QL0); S.sAm = (size_t)256 * LDH * 2; S.B0 = (const char*)(ws + OFF_WB); S.sBn = (size_t)256 * LDWB * 2;
    g8::EpiBf16 E{(bf16_t*)(ws + OFF_RQ), (bf16_t*)(ws + OFF_RZ), 16, 4096, ss + T};
    g8::gemm_phase(gl, 2048, LDH, LDWB, S, E);
  }
  grid_bar(bar, (unsigned)(6 * nb));

  REPS(8) { p8_pool(p, bid, nb); }
  grid_bar(bar, (unsigned)(7 * nb));

  REPS(9) {
    g8::Sched S; S.init(128, 8, nb, bid); S.A0 = (const char*)p.out; S.sAm = (size_t)256 * 4096 * 2; S.B0 = (const char*)(ws + OFF_WOUTB); S.sBn = (size_t)256 * 4096 * 2;
    g8::EpiRes E{nullptr, (const bf16_t*)(ws + OFF_QL0), LDH, nullptr, (bf16_t*)(ws + OFF_RQ), 2048, ss + 2 * T, 1.f};
    g8::gemm_phase(gl, 4096, 4096, 4096, S, E);
  }
  grid_bar(bar, (unsigned)(8 * nb));

  p10_final(p, bid, nb);
}

extern "C" void kernel_launch(void* const* d_in, const int* in_sizes, int n_in,
                              void* d_out, int out_size, void* d_ws, size_t ws_size,
                              hipStream_t stream) {
  static int grid_blocks = 0;
  if (!grid_blocks) {
    int dev = 0, cus = 0, per_cu = 0;
    (void)hipGetDevice(&dev);
    (void)hipDeviceGetAttribute(&cus, hipDeviceAttributeMultiprocessorCount, dev);
    (void)hipFuncSetAttribute((const void*)fwd_mega, hipFuncAttributeMaxDynamicSharedMemorySize, LDS_BYTES);
    (void)hipOccupancyMaxActiveBlocksPerMultiprocessor(&per_cu, (const void*)fwd_mega, 512, LDS_BYTES);
    if (per_cu < 1) per_cu = 1;
    grid_blocks = cus * per_cu;
    if (ws_size < WS_END) fprintf(stderr, "kernel_launch: workspace too small: %zu < %zu\n", ws_size, (size_t)WS_END);
  }
  Params p{};
  p.x = (const float*)d_in[0]; p.norm_a = (const float*)d_in[1]; p.w_in_a = (const float*)d_in[2]; p.kv_norm = (const float*)d_in[3];
  p.kidx_norm = (const float*)d_in[4]; p.w_uk = (const float*)d_in[5]; p.w_uv = (const float*)d_in[6]; p.w_out_a = (const float*)d_in[7];
  p.norm_b = (const float*)d_in[8]; p.w_in_b = (const float*)d_in[9]; p.w_grp = (const float*)d_in[10]; p.b_grp = (const float*)d_in[11];
  p.scale_b = (const float*)d_in[12]; p.w_out_b = (const float*)d_in[13]; p.rel_bias = (const float*)d_in[14]; p.final_norm = (const float*)d_in[15];
  p.out = (float*)d_out; p.ws = (unsigned char*)d_ws; p.probe = PROBE_PHASE; p.pad = 0;
  void* args[] = {&p};
  hipError_t e = hipLaunchCooperativeKernel((void*)fwd_mega, dim3(grid_blocks), dim3(512), args, LDS_BYTES, stream);
  if (e != hipSuccess) fprintf(stderr, "cooperative launch failed: %s (grid %d)\n", hipGetErrorString(e), grid_blocks);
}
```
